# Optimizing an MI355X kernel written in HIP

```python
import math
import jax, jax.numpy as jnp
from jax import lax
import numpy as np

D_MODEL = 1024
BATCH = 8
SEQ = 8192
DEPTH = 2

HEAD_DIM = 64
N_SLOTS = D_MODEL // HEAD_DIM
SB_HEADS = N_SLOTS // 2
SB_WIDTH = SB_HEADS * HEAD_DIM
DIFF_HEADS = N_SLOTS // 4
DIFF_VDIM = 2 * HEAD_DIM
DIFF_WIDTH = DIFF_HEADS * DIFF_VDIM
DIFF_QK_WIDTH = DIFF_HEADS * 2 * HEAD_DIM
EVEN_IN = 3 * SB_WIDTH + 2 * DIFF_QK_WIDTH + DIFF_WIDTH
DIL_HEADS = N_SLOTS
ODD_IN = 3 * DIL_HEADS * HEAD_DIM
DIL_BRANCHES = ((128, 1), (512, 4), (2048, 16))
W_MAX = 2048
Q_BLOCK = 128
NUM_BUCKETS = 32
MAX_DISTANCE = 128
D_FF = 4 * D_MODEL
PLE_DIM = 256
N_EVEN = (DEPTH + 1) // 2
N_ODD = DEPTH // 2
NORM_EPS = 1e-6
SUBLN_EPS = 1e-5
NEG = -1e30

kernel_name = "hybrid_stickbreak_diff_dilated_trunk"


def rmsnorm(x, g, eps=NORM_EPS):
    x32 = x.astype(jnp.float32)
    y = x32 * lax.rsqrt(jnp.mean(x32 * x32, axis=-1, keepdims=True) + eps) * g.astype(jnp.float32)
    return y.astype(x.dtype)


def t5_bucket(dist):
    n = jnp.maximum(dist, 0)
    max_exact = NUM_BUCKETS // 2
    nf = jnp.maximum(n, 1).astype(jnp.float32)
    large = max_exact + (jnp.log(nf / max_exact) / math.log(MAX_DISTANCE / max_exact)
                         * (NUM_BUCKETS - max_exact)).astype(jnp.int32)
    large = jnp.minimum(large, NUM_BUCKETS - 1)
    return jnp.where(n < max_exact, n, large)


def even_mixer(h, w_in, w_out, lq1, lk1, lq2, lk2, subln_g, t5_table, layer_idx):
    B, S, _ = h.shape
    f32 = jnp.float32
    proj = h @ w_in
    cuts = np.cumsum([SB_WIDTH, SB_WIDTH, SB_WIDTH, DIFF_QK_WIDTH, DIFF_QK_WIDTH]).tolist()
    qa, ka, va, qb, kb, vb = jnp.split(proj, cuts, axis=-1)
    qa = qa.reshape(B, S, SB_HEADS, HEAD_DIM).astype(f32)
    ka = ka.reshape(B, S, SB_HEADS, HEAD_DIM).astype(f32)
    va = va.reshape(B, S, SB_HEADS, HEAD_DIM).astype(f32)
    qb = qb.reshape(B, S, DIFF_HEADS, 2, HEAD_DIM).astype(f32)
    kb = kb.reshape(B, S, DIFF_HEADS, 2, HEAD_DIM).astype(f32)
    vb = vb.reshape(B, S, DIFF_HEADS, DIFF_VDIM).astype(f32)
    scale = HEAD_DIM ** -0.5
    lambda_init = 0.8 - 0.6 * math.exp(-0.3 * layer_idx)
    lam = (jnp.exp(jnp.sum(lq1.astype(f32) * lk1.astype(f32)))
           - jnp.exp(jnp.sum(lq2.astype(f32) * lk2.astype(f32))) + lambda_init)
    table = t5_table.astype(f32)
    kpos = jnp.arange(S)

    def block(i):
        t0 = i * Q_BLOCK
        qpos = t0 + jnp.arange(Q_BLOCK)
        rel = qpos[:, None] - kpos[None, :]
        qa_b = lax.dynamic_slice_in_dim(qa, t0, Q_BLOCK, axis=1)
        z = jnp.einsum('bqhd,bkhd->bhqk', qa_b, ka) * scale
        strict = rel > 0
        log_keep = jnp.where(strict, -jax.nn.softplus(z), 0.0)
        later = lax.cumsum(log_keep, axis=3, reverse=True) - log_keep
        w_sb = jnp.where(strict, jnp.exp(jax.nn.log_sigmoid(z) + later), 0.0)
        o_sb = jnp.einsum('bhqk,bkhd->bqhd', w_sb, va)
        qb_b = lax.dynamic_slice_in_dim(qb, t0, Q_BLOCK, axis=1)
        sc = jnp.einsum('bqhmd,bkhmd->bhmqk', qb_b, kb) * scale
        bias = table[t5_bucket(rel)]
        bias = bias[..., SB_HEADS:].reshape(Q_BLOCK, S, DIFF_HEADS, 2).transpose(2, 3, 0, 1)
        sc = jnp.where(rel >= 0, sc + bias, NEG)
        prob = jax.nn.softmax(sc, axis=-1)
        attn = prob[:, :, 0] - lam * prob[:, :, 1]
        o_d = jnp.einsum('bhqk,bkhd->bqhd', attn, vb)
        o_d = rmsnorm(o_d, subln_g, SUBLN_EPS) * (1.0 - lambda_init)
        return jnp.concatenate([o_sb.reshape(B, Q_BLOCK, SB_WIDTH),
                                o_d.reshape(B, Q_BLOCK, DIFF_WIDTH)], axis=-1)

    o = lax.map(block, jnp.arange(S // Q_BLOCK))
    o = o.transpose(1, 0, 2, 3).reshape(B, S, SB_WIDTH + DIFF_WIDTH).astype(h.dtype)
    return o @ w_out


def odd_mixer(h, w_in, w_out, t5_table):
    B, S, _ = h.shape
    f32 = jnp.float32
    q, k, v = jnp.split(h @ w_in, 3, axis=-1)
    q = q.reshape(B, S, DIL_HEADS, HEAD_DIM).astype(f32)
    k = k.reshape(B, S, DIL_HEADS, HEAD_DIM).astype(f32)
    v = v.reshape(B, S, DIL_HEADS, HEAD_DIM).astype(f32)
    pad = ((0, 0), (W_MAX, 0), (0, 0), (0, 0))
    kp = jnp.pad(k, pad)
    vp = jnp.pad(v, pad)
    scale = HEAD_DIM ** -0.5
    table = t5_table.astype(f32)

    def block(i):
        t0 = i * Q_BLOCK
        q_b = lax.dynamic_slice_in_dim(q, t0, Q_BLOCK, axis=1)
        outs, lses = [], []
        for (w, r) in DIL_BRANCHES:
            L = w + Q_BLOCK
            nq, nk = Q_BLOCK // r, L // r
            k_s = lax.dynamic_slice_in_dim(kp, t0 + W_MAX - w, L, axis=1).reshape(B, nk, r, DIL_HEADS, HEAD_DIM)
            v_s = lax.dynamic_slice_in_dim(vp, t0 + W_MAX - w, L, axis=1).reshape(B, nk, r, DIL_HEADS, HEAD_DIM)
            q_s = q_b.reshape(B, nq, r, DIL_HEADS, HEAD_DIM)
            sc = jnp.einsum('bqchd,bkchd->bhcqk', q_s, k_s) * scale
            dist = w + (jnp.arange(nq)[:, None] - jnp.arange(nk)[None, :]) * r
            keypos = t0 - w + jnp.arange(nk)[None, :] * r + jnp.arange(r)[:, None]
            valid = ((dist >= 0) & (dist <= w))[None] & (keypos >= 0)[:, None, :]
            bias = table[t5_bucket(dist)].transpose(2, 0, 1)[:, None]
            sc = jnp.where(valid, sc + bias, NEG)
            lse = jax.nn.logsumexp(sc, axis=-1, keepdims=True)
            pr = jnp.exp(sc - lse)
            o = jnp.einsum('bhcqk,bkchd->bqchd', pr, v_s).reshape(B, Q_BLOCK, DIL_HEADS, HEAD_DIM)
            lse = lse[..., 0].transpose(0, 3, 2, 1).reshape(B, Q_BLOCK, DIL_HEADS)
            outs.append(o)
            lses.append(lse)
        wts = jax.nn.softmax(jnp.stack(lses, axis=0), axis=0)
        o = jnp.sum(wts[..., None] * jnp.stack(outs, axis=0), axis=0)
        return o.reshape(B, Q_BLOCK, DIL_HEADS * HEAD_DIM)

    o = lax.map(block, jnp.arange(S // Q_BLOCK))
    o = o.transpose(1, 0, 2, 3).reshape(B, S, DIL_HEADS * HEAD_DIM).astype(h.dtype)
    return o @ w_out


def setup_inputs(seed: int = 0) -> dict:
    key = jax.random.key(seed)
    ks = jax.random.split(key, 24)
    nrm = jax.random.normal
    f32 = jnp.float32
    D = D_MODEL
    return {
        "x": nrm(ks[0], (BATCH, SEQ, D), f32),
        "p": nrm(ks[1], (DEPTH, BATCH, SEQ, PLE_DIM), f32),
        "t5_table": 0.5 * nrm(ks[2], (NUM_BUCKETS, N_SLOTS), f32),
        "w_in_even": nrm(ks[3], (N_EVEN, D, EVEN_IN), f32) * D ** -0.5,
        "w_out_even": nrm(ks[4], (N_EVEN, SB_WIDTH + DIFF_WIDTH, D), f32) * (SB_WIDTH + DIFF_WIDTH) ** -0.5,
        "lambda_q1": 0.1 * nrm(ks[5], (N_EVEN, HEAD_DIM), f32),
        "lambda_k1": 0.1 * nrm(ks[6], (N_EVEN, HEAD_DIM), f32),
        "lambda_q2": 0.1 * nrm(ks[7], (N_EVEN, HEAD_DIM), f32),
        "lambda_k2": 0.1 * nrm(ks[8], (N_EVEN, HEAD_DIM), f32),
        "subln_g": 1.0 + 0.02 * nrm(ks[9], (N_EVEN, DIFF_VDIM), f32),
        "w_in_odd": nrm(ks[10], (N_ODD, D, ODD_IN), f32) * D ** -0.5,
        "w_out_odd": nrm(ks[11], (N_ODD, DIL_HEADS * HEAD_DIM, D), f32) * (DIL_HEADS * HEAD_DIM) ** -0.5,
        "norm_mix_g": 1.0 + 0.02 * nrm(ks[12], (DEPTH, D), f32),
        "norm_mlp_g": 1.0 + 0.02 * nrm(ks[13], (DEPTH, D), f32),
        "w_mlp_up": nrm(ks[14], (DEPTH, D, D_FF), f32) * D ** -0.5,
        "w_mlp_down": nrm(ks[15], (DEPTH, D_FF, D), f32) * D_FF ** -0.5,
        "norm_ple_g": 1.0 + 0.02 * nrm(ks[16], (DEPTH, D), f32),
        "w_ple_gate": nrm(ks[17], (DEPTH, D, D), f32) * D ** -0.5,
        "w_ple_proj": nrm(ks[18], (DEPTH, PLE_DIM, D), f32) * PLE_DIM ** -0.5,
        "final_norm_g": 1.0 + 0.02 * nrm(ks[19], (D,), f32),
    }


def reference(x, p, t5_table, w_in_even, w_out_even, lambda_q1, lambda_k1, lambda_q2, lambda_k2,
              subln_g, w_in_odd, w_out_odd, norm_mix_g, norm_mlp_g, w_mlp_up, w_mlp_down,
              norm_ple_g, w_ple_gate, w_ple_proj, final_norm_g):
    h = x
    for i in range(DEPTH):
        hn = rmsnorm(h, norm_mix_g[i])
        if i % 2 == 0:
            e = i // 2
            h = h + even_mixer(hn, w_in_even[e], w_out_even[e], lambda_q1[e], lambda_k1[e],
                               lambda_q2[e], lambda_k2[e], subln_g[e], t5_table, i)
        else:
            o = i // 2
            h = h + odd_mixer(hn, w_in_odd[o], w_out_odd[o], t5_table)
        hn = rmsnorm(h, norm_mlp_g[i])
        u = jnp.square(jax.nn.relu(hn @ w_mlp_up[i]))
        h = h + u @ w_mlp_down[i]
        gate = jax.nn.sigmoid(rmsnorm(h, norm_ple_g[i]) @ w_ple_gate[i])
        h = h + (p[i] @ w_ple_proj[i]) * gate
    return rmsnorm(h, final_norm_g)
```

```cpp
#include <hip/hip_runtime.h>
#include <hip/hip_cooperative_groups.h>
#include <cstdio>
#include <cstdint>
namespace cg = cooperative_groups;
namespace pg8 {
#define PG8_LAS __attribute__((address_space(3)))
typedef unsigned short bf16_t;
typedef short bf16x8 __attribute__((ext_vector_type(8)));
typedef float f32x4 __attribute__((ext_vector_type(4)));
typedef unsigned u32x4 __attribute__((ext_vector_type(4)));
constexpr int BM = 256, BK = 64, HALF = 128, HTB = HALF * BK * 2  , STAGE_BYTES = 8 * HTB, NXCD = 8, WGM = 8;

__host__ __device__ __forceinline__ int lds_byte(int r, int c) { const int st = (r >> 4) * 2 + (c >> 5), rr = r & 15, cc = c & 31, ob = rr * 64 + cc * 2; return st * 1024 + (ob ^ (((ob >> 9) & 1) << 5)); }
__host__ __device__ __forceinline__ void stage_rc(int b, int& R, int& C) { const int st = b / 1024, sb = b % 1024, swz = sb ^ (((sb >> 9) & 1) << 5); R = (st >> 1) * 16 + swz / 64; C = (st & 1) * 32 + (swz % 64) / 2; }
__host__ __device__ __forceinline__ int perm32(int rho) { const int n = rho >> 4, i = rho & 15; return 8 * (i >> 2) + 4 * n + (i & 3); }

struct Unit { int pm, pn; };
struct Gemm { const bf16_t* A; const bf16_t* Bt; int M, N, K; };

struct StaticOrder {
    int nM, nN, nwg, G, c;
    __host__ __device__ void init(int M, int N, int G_, int c_) { nM = M / BM; nN = N / BM; nwg = nM * nN; G = G_; c = c_; }
    __host__ __device__ bool next(int i, Unit& u) const {
        const long L = (long)i * G + c; if (L >= nwg) return false;
        int wgid = (int)L; { const int q = nwg / NXCD, r = nwg % NXCD, xcd = wgid % NXCD, off = wgid / NXCD; wgid = (xcd < r ? xcd * (q + 1) : r * (q + 1) + (xcd - r) * q) + off; }
        const int nig = WGM * nN, gid = wgid / nig, fm = gid * WGM, gsz = (nM - fm) < WGM ? (nM - fm) : WGM;
        u.pm = fm + ((wgid % nig) % gsz); u.pn = (wgid % nig) / gsz; return true;
    }
    __device__ __forceinline__ void a_ready(const Unit&) const {}
    __device__ __forceinline__ void done(const Unit&) const {}
};

__device__ __forceinline__ unsigned cvt_pk_bf16(float lo, float hi) { unsigned r; asm volatile("v_cvt_pk_bf16_f32 %0, %1, %2" : "=v"(r) : "v"(lo), "v"(hi)); return r; }
__device__ __forceinline__ float row_rstd(const float* ss, int row) { return __builtin_amdgcn_rsqf(ss[row] * (1.0f / 1024.0f) + 1e-6f); }
template <int ACT  , bool TILED = false  > struct EpiNormBf16 {
    static constexpr bool PERM = true, AFTER_DRAIN = false;
    bf16_t* O; int ldc; const float* ss;
    __device__ __forceinline__ void operator()(const f32x4 (&acc)[2][2][4][2], const Unit& u, int wr, int wc, int fr, int fq) const {
        const int row0 = u.pm * BM + wr * 64 + fr, col0 = u.pn * BM + wc * 32 + 8 * fq;
        float rsv[8];
#pragma unroll
        for (int i = 0; i < 8; ++i) rsv[i] = ss ? ss[row0 + (i >> 2) * HALF + (i & 3) * 16] : 1.0f;
#pragma unroll
        for (int i = 0; i < 8; ++i) rsv[i] = ss ? __builtin_amdgcn_rsqf(rsv[i] * (1.0f / 1024.0f) + 1e-6f) : 1.0f;
#pragma unroll
        for (int ai = 0; ai < 2; ++ai)
#pragma unroll
            for (int m = 0; m < 4; ++m) {
                const int row = row0 + ai * HALF + m * 16;
                const float rs = rsv[ai * 4 + m];
                bf16_t* rowp = TILED ? O + (size_t)u.pn * ((size_t)ldc * BM) + (size_t)row * BM + (col0 - u.pn * BM) : O + (size_t)row * ldc + col0;
#pragma unroll
                for (int bj = 0; bj < 2; ++bj) {
                    f32x4 v0 = acc[ai][bj][m][0] * rs, v1 = acc[ai][bj][m][1] * rs;
                    if (ACT == 1) {
#pragma unroll
                        for (int e = 0; e < 4; ++e) { const float a = fmaxf(v0[e], 0.f), b = fmaxf(v1[e], 0.f); v0[e] = a * a; v1[e] = b * b; }
                    }
                    u32x4 w; w.x = cvt_pk_bf16(v0[0], v0[1]); w.y = cvt_pk_bf16(v0[2], v0[3]); w.z = cvt_pk_bf16(v1[0], v1[1]); w.w = cvt_pk_bf16(v1[2], v1[3]);
                    *(u32x4*)(rowp + bj * HALF) = w;
                }
            }
    }
};
__device__ __forceinline__ void unpack8(const u32x4 pw, f32x4& p0, f32x4& p1) {
    p0[0] = __uint_as_float(pw.x << 16); p0[1] = __uint_as_float(pw.x & 0xffff0000u); p0[2] = __uint_as_float(pw.y << 16); p0[3] = __uint_as_float(pw.y & 0xffff0000u);
    p1[0] = __uint_as_float(pw.z << 16); p1[1] = __uint_as_float(pw.z & 0xffff0000u); p1[2] = __uint_as_float(pw.w << 16); p1[3] = __uint_as_float(pw.w & 0xffff0000u);
}
template <bool BASE_F32> struct EpiResid {
    static constexpr bool PERM = true, AFTER_DRAIN = false;
    const float* basef; const bf16_t* baseb; bf16_t* hb; float* ss_out;
    __device__ __forceinline__ void operator()(const f32x4 (&acc)[2][2][4][2], const Unit& u, int wr, int wc, int fr, int fq) const {
        const int row0 = u.pm * BM + wr * 64 + fr, col0 = u.pn * BM + wc * 32 + 8 * fq;
#pragma unroll
        for (int ai = 0; ai < 2; ++ai) {
            f32x4 bv[4][2][2];
#pragma unroll
            for (int m = 0; m < 4; ++m)
#pragma unroll
                for (int bj = 0; bj < 2; ++bj) {
                    const size_t off = (size_t)(row0 + ai * HALF + m * 16) * 1024 + col0 + bj * HALF;
                    if (BASE_F32) { bv[m][bj][0] = *(const f32x4*)(basef + off); bv[m][bj][1] = *(const f32x4*)(basef + off + 4); }
                    else { const u32x4 w = *(const u32x4*)(baseb + off); bv[m][bj][0] = __builtin_bit_cast(f32x4, w); }
                }
#pragma unroll
            for (int m = 0; m < 4; ++m) {
                const int row = row0 + ai * HALF + m * 16; float sq = 0.f;
#pragma unroll
                for (int bj = 0; bj < 2; ++bj) {
                    const size_t off = (size_t)row * 1024 + col0 + bj * HALF;
                    f32x4 b0, b1;
                    if (BASE_F32) { b0 = bv[m][bj][0]; b1 = bv[m][bj][1]; } else unpack8(__builtin_bit_cast(u32x4, bv[m][bj][0]), b0, b1);
                    const f32x4 v0 = acc[ai][bj][m][0] + b0, v1 = acc[ai][bj][m][1] + b1;
                    u32x4 w; w.x = cvt_pk_bf16(v0[0], v0[1]); w.y = cvt_pk_bf16(v0[2], v0[3]); w.z = cvt_pk_bf16(v1[0], v1[1]); w.w = cvt_pk_bf16(v1[2], v1[3]);
                    *(u32x4*)(hb + off) = w;
                    sq += (v0[0] * v0[0] + v0[1] * v0[1]) + (v0[2] * v0[2] + v0[3] * v0[3]) + (v1[0] * v1[0] + v1[1] * v1[1]) + (v1[2] * v1[2] + v1[3] * v1[3]);
                }
                sq += __shfl_xor(sq, 16); sq += __shfl_xor(sq, 32);
                if (fq == 0) unsafeAtomicAdd(ss_out + row, sq);
            }
        }
    }
};
struct EpiGate {
    static constexpr bool PERM = true, AFTER_DRAIN = false;
    const bf16_t* baseb; bf16_t* hb; float* ss_out; const float* ss_in; const bf16_t* pp;
    __device__ __forceinline__ void operator()(const f32x4 (&acc)[2][2][4][2], const Unit& u, int wr, int wc, int fr, int fq) const {
        const int row0 = u.pm * BM + wr * 64 + fr, col0 = u.pn * BM + wc * 32 + 8 * fq;
        float rsv[8];
#pragma unroll
        for (int i = 0; i < 8; ++i) rsv[i] = ss_in[row0 + (i >> 2) * HALF + (i & 3) * 16];
#pragma unroll
        for (int ai = 0; ai < 2; ++ai) {
            u32x4 bw[4][2], pw[4][2];
#pragma unroll
            for (int m = 0; m < 4; ++m)
#pragma unroll
                for (int bj = 0; bj < 2; ++bj) {
                    const size_t off = (size_t)(row0 + ai * HALF + m * 16) * 1024 + col0 + bj * HALF;
                    bw[m][bj] = *(const u32x4*)(baseb + off); pw[m][bj] = *(const u32x4*)(pp + off);
                }
#pragma unroll
            for (int m = 0; m < 4; ++m) {
                const int row = row0 + ai * HALF + m * 16; float sq = 0.f;
                const float rs = __builtin_amdgcn_rsqf(rsv[ai * 4 + m] * (1.0f / 1024.0f) + 1e-6f) * (-1.4426950408889634f);
#pragma unroll
                for (int bj = 0; bj < 2; ++bj) {
                    const size_t off = (size_t)row * 1024 + col0 + bj * HALF;
                    f32x4 p0, p1, b0, b1;
                    unpack8(pw[m][bj], p0, p1); unpack8(bw[m][bj], b0, b1);
                    f32x4 v0, v1;
#pragma unroll
                    for (int e = 0; e < 4; ++e) {
                        const float g0 = __builtin_amdgcn_rcpf(1.0f + __builtin_amdgcn_exp2f(acc[ai][bj][m][0][e] * rs));
                        const float g1 = __builtin_amdgcn_rcpf(1.0f + __builtin_amdgcn_exp2f(acc[ai][bj][m][1][e] * rs));
                        v0[e] = b0[e] + p0[e] * g0; v1[e] = b1[e] + p1[e] * g1;
                    }
                    u32x4 w; w.x = cvt_pk_bf16(v0[0], v0[1]); w.y = cvt_pk_bf16(v0[2], v0[3]); w.z = cvt_pk_bf16(v1[0], v1[1]); w.w = cvt_pk_bf16(v1[2], v1[3]); *(u32x4*)(hb + off) = w;
                    sq += (v0[0] * v0[0] + v0[1] * v0[1]) + (v0[2] * v0[2] + v0[3] * v0[3]) + (v1[0] * v1[0] + v1[1] * v1[1]) + (v1[2] * v1[2] + v1[3] * v1[3]);
                }
                sq += __shfl_xor(sq, 16); sq += __shfl_xor(sq, 32);
                if (fq == 0) unsafeAtomicAdd(ss_out + row, sq);
            }
        }
    }
};
template <class Epi, class Sched, bool ALIGN_EPI = false, bool SP2 = false>
__device__ __forceinline__ void gemm_phase(PG8_LAS unsigned char* lds, const Gemm g, const Sched& S, const Epi& E) {
    int tid_ = threadIdx.x; asm volatile("" : "+v"(tid_));
    const int tid = tid_, wid = __builtin_amdgcn_readfirstlane(tid >> 6), lane = tid & 63, wr = wid >> 2, wc = wid & 3, fr = lane & 15, fq = lane >> 4;
    const int K = g.K, nt = K / BK;
    unsigned voffA[2], voffB[2];
#pragma unroll
    for (int i = 0; i < 2; ++i) { int R, C; stage_rc(tid * 16 + i * 8192, R, C); const int Rb = Epi::PERM ? ((R & ~31) + perm32(R & 31)) : R;
        voffA[i] = (unsigned)(R * K + C) * 2u; voffB[i] = (unsigned)(Rb * K + C) * 2u; }
    const size_t kstep = (size_t)(BK * 2);
    const size_t hstep = (size_t)HALF * K * 2;
    const size_t tstep = 2 * hstep;
    const unsigned ldsw = (unsigned)wid * 1024u;
    const int aoff = lds_byte(wr * 64 + fr, fq * 8), boff = lds_byte(wc * 32 + fr, fq * 8);
#define PG8_SA(b, h) (((b) * 2 + (h)) * HTB)
#define PG8_SB(b, h) ((4 + (b) * 2 + (h)) * HTB)
#define PG8_STAGE(bufoff, gbase, voff) do { _Pragma("unroll") for (int _i = 0; _i < 2; ++_i) \
        __builtin_amdgcn_global_load_lds((const unsigned*)((const char*)(gbase) + (voff)[_i]), (PG8_LAS unsigned*)(lds + (bufoff) + ldsw + _i * 8192), 16, 0, 0); } while (0)
#define PG8_LDA(dst, b, h) do { _Pragma("unroll") for (int m = 0; m < 4; ++m) _Pragma("unroll") for (int k = 0; k < 2; ++k) dst[m][k] = *(const PG8_LAS bf16x8*)(lds + PG8_SA(b, h) + aoff + m * 2048 + k * 1024); } while (0)
#define PG8_LDB(dst, b, h) do { _Pragma("unroll") for (int n = 0; n < 2; ++n) _Pragma("unroll") for (int k = 0; k < 2; ++k) dst[n][k] = *(const PG8_LAS bf16x8*)(lds + PG8_SB(b, h) + boff + n * 2048 + k * 1024); } while (0)
#define PG8_MMA(ai, bj, At, Bt) do { __builtin_amdgcn_s_setprio(1); _Pragma("unroll") for (int m = 0; m < 4; ++m) _Pragma("unroll") for (int n = 0; n < 2; ++n) _Pragma("unroll") for (int k = 0; k < 2; ++k) \
        acc[ai][bj][m][n] = __builtin_amdgcn_mfma_f32_16x16x32_bf16(Bt[n][k], At[m][k], acc[ai][bj][m][n], 0, 0, 0); __builtin_amdgcn_s_setprio(0); } while (0)
#define PG8_WAIT_V(n) asm volatile("s_waitcnt vmcnt(" #n ")" ::: "memory")
#define PG8_WAIT_L(n) asm volatile("s_waitcnt lgkmcnt(" #n ")" ::: "memory")
#define PG8_BAR __builtin_amdgcn_s_barrier()
#define PG8_SCHED __builtin_amdgcn_sched_barrier(0)
    Unit cur, nxt; int ui = 0;
    if (!S.next(0, cur)) return;
    f32x4 acc[2][2][4][2];
#pragma unroll
    for (int a = 0; a < 2; ++a)
#pragma unroll
        for (int b = 0; b < 2; ++b)
#pragma unroll
            for (int m = 0; m < 4; ++m)
#pragma unroll
                for (int n = 0; n < 2; ++n) acc[a][b][m][n] = (f32x4){0.f, 0.f, 0.f, 0.f};
    bf16x8 At[4][2], B0[2][2], B1[2][2];
    const char* cA = (const char*)g.A + (size_t)cur.pm * tstep; const char* cB = (const char*)g.Bt + (size_t)cur.pn * tstep;
    S.a_ready(cur);
    if constexpr (SP2) {
        PG8_STAGE(PG8_SB(0, 0), cB, voffB); PG8_STAGE(PG8_SB(0, 1), cB + hstep, voffB); PG8_STAGE(PG8_SA(0, 0), cA, voffA); PG8_STAGE(PG8_SA(0, 1), cA + hstep, voffA);
        if (wr == 1) PG8_BAR;
        PG8_WAIT_V(2); PG8_BAR;
        PG8_STAGE(PG8_SB(1, 0), cB + kstep, voffB); PG8_STAGE(PG8_SA(1, 0), cA + kstep, voffA); PG8_STAGE(PG8_SB(1, 1), cB + hstep + kstep, voffB);
        PG8_WAIT_V(6); PG8_BAR;
    } else {
        PG8_STAGE(PG8_SB(0, 0), cB, voffB); PG8_STAGE(PG8_SA(0, 0), cA, voffA); PG8_STAGE(PG8_SB(0, 1), cB + hstep, voffB); PG8_STAGE(PG8_SA(0, 1), cA + hstep, voffA);
        if (wr == 1) PG8_BAR;
        PG8_WAIT_V(4); PG8_BAR;
        PG8_STAGE(PG8_SB(1, 0), cB + kstep, voffB); PG8_STAGE(PG8_SA(1, 0), cA + kstep, voffA); PG8_STAGE(PG8_SB(1, 1), cB + hstep + kstep, voffB);
        PG8_WAIT_V(6); PG8_BAR;
    }
    for (;;) {
        const bool has_next = S.next(ui + 1, nxt);
        const char* nA = has_next ? (const char*)g.A + (size_t)nxt.pm * tstep : cA; const char* nB = has_next ? (const char*)g.Bt + (size_t)nxt.pn * tstep : cB;
        for (int t = 0; t < nt; t += 2) {
            const bool last = (t == nt - 2);
            const char* a1 = cA + (size_t)(t + 1) * kstep;
            const char* a2 = last ? nA : cA + (size_t)(t + 2) * kstep; const char* b2 = last ? nB : cB + (size_t)(t + 2) * kstep;
            const char* a3 = a2 + kstep; const char* b3 = b2 + kstep;
            if (last && has_next) S.a_ready(nxt);
            if constexpr (SP2) {
            PG8_LDB(B0, 0, 0); PG8_LDB(B1, 0, 1); PG8_SCHED; PG8_LDA(At, 0, 0); PG8_STAGE(PG8_SA(1, 1), a1 + hstep, voffA);
            PG8_WAIT_V(8); PG8_WAIT_L(0); PG8_BAR; PG8_MMA(0, 0, At, B0); PG8_MMA(0, 1, At, B1); PG8_BAR; PG8_SCHED;
            PG8_LDA(At, 0, 1); PG8_STAGE(PG8_SB(0, 0), b2, voffB); PG8_STAGE(PG8_SB(0, 1), b2 + hstep, voffB); PG8_STAGE(PG8_SA(0, 0), a2, voffA);
            PG8_WAIT_V(8); PG8_WAIT_L(0); PG8_BAR; PG8_MMA(1, 0, At, B0); PG8_MMA(1, 1, At, B1); PG8_BAR; PG8_SCHED;
            PG8_LDB(B0, 1, 0); PG8_LDB(B1, 1, 1); PG8_SCHED; PG8_LDA(At, 1, 0); PG8_STAGE(PG8_SA(0, 1), a2 + hstep, voffA);
            PG8_WAIT_V(8); PG8_WAIT_L(0); PG8_BAR; PG8_MMA(0, 0, At, B0); PG8_MMA(0, 1, At, B1); PG8_BAR; PG8_SCHED;
            PG8_LDA(At, 1, 1); PG8_STAGE(PG8_SB(1, 0), b3, voffB); PG8_STAGE(PG8_SB(1, 1), b3 + hstep, voffB); PG8_STAGE(PG8_SA(1, 0), a3, voffA);
            PG8_WAIT_V(8); PG8_WAIT_L(0); PG8_BAR; PG8_MMA(1, 0, At, B0); PG8_MMA(1, 1, At, B1); PG8_BAR; PG8_SCHED;
            } else {
            PG8_LDB(B0, 0, 0); PG8_SCHED; PG8_LDA(At, 0, 0); PG8_STAGE(PG8_SA(1, 1), a1 + hstep, voffA);
            PG8_WAIT_L(8); PG8_BAR; PG8_WAIT_L(0); PG8_MMA(0, 0, At, B0); PG8_BAR; PG8_SCHED;
            PG8_LDB(B1, 0, 1); PG8_STAGE(PG8_SB(0, 0), b2, voffB);
            PG8_BAR; PG8_WAIT_L(0); PG8_MMA(0, 1, At, B1); PG8_BAR;
            PG8_LDA(At, 0, 1); PG8_STAGE(PG8_SA(0, 0), a2, voffA);
            PG8_BAR; PG8_WAIT_L(0); PG8_MMA(1, 0, At, B0); PG8_BAR; PG8_SCHED;
            PG8_STAGE(PG8_SB(0, 1), b2 + hstep, voffB);
            PG8_WAIT_V(6); PG8_BAR; PG8_MMA(1, 1, At, B1); PG8_BAR;
            PG8_LDB(B0, 1, 0); PG8_SCHED; PG8_LDA(At, 1, 0); PG8_STAGE(PG8_SA(0, 1), a2 + hstep, voffA);
            PG8_WAIT_L(8); PG8_BAR; PG8_WAIT_L(0); PG8_MMA(0, 0, At, B0); PG8_BAR; PG8_SCHED;
            PG8_LDB(B1, 1, 1); PG8_STAGE(PG8_SB(1, 0), b3, voffB);
            PG8_BAR; PG8_WAIT_L(0); PG8_MMA(0, 1, At, B1); PG8_BAR;
            PG8_LDA(At, 1, 1); PG8_STAGE(PG8_SA(1, 0), a3, voffA);
            PG8_BAR; PG8_WAIT_L(0); PG8_MMA(1, 0, At, B0); PG8_BAR; PG8_SCHED;
            PG8_STAGE(PG8_SB(1, 1), b3 + hstep, voffB);
            PG8_WAIT_V(6); PG8_BAR; PG8_MMA(1, 1, At, B1); PG8_BAR;
            }
        }
        if constexpr (ALIGN_EPI) { if (wr == 0) PG8_BAR; }
        if constexpr (!Epi::AFTER_DRAIN) { E(acc, cur, wr, wc, fr, fq); S.done(cur); }
        if (!has_next) break;
#pragma unroll
        for (int a = 0; a < 2; ++a)
#pragma unroll
            for (int b = 0; b < 2; ++b)
#pragma unroll
                for (int m = 0; m < 4; ++m)
#pragma unroll
                    for (int n = 0; n < 2; ++n) acc[a][b][m][n] = (f32x4){0.f, 0.f, 0.f, 0.f};
        cur = nxt; cA = nA; cB = nB; ++ui;
        if constexpr (ALIGN_EPI) { if (wr == 1) PG8_BAR; }
    }
    PG8_WAIT_V(0);
    if constexpr (!ALIGN_EPI) { if (wr == 0) PG8_BAR; }
    PG8_BAR;
    if constexpr (Epi::AFTER_DRAIN) { E.fused(acc, cur, wr, wc, fr, fq, lds, wid, lane); S.done(cur); }
#undef PG8_SA
#undef PG8_SB
#undef PG8_STAGE
#undef PG8_LDA
#undef PG8_LDB
#undef PG8_MMA
#undef PG8_WAIT_V
#undef PG8_WAIT_L
#undef PG8_BAR
#undef PG8_SCHED
}
}
constexpr int NB = 8, SEQ = 8192, DM = 1024, MTOK = NB * SEQ, NPROJ = 3072, DFF = 4096, PLED = 256;
constexpr float LOG2E = 1.4426950408889634f, LN2 = 0.6931471805599453f;
constexpr int LUTS = 132;

namespace att {
#define LAS __attribute__((address_space(3)))
#define DI __device__ __forceinline__
typedef unsigned short bf16_t;
typedef short bf16x8 __attribute__((ext_vector_type(8)));
typedef short s16x4 __attribute__((ext_vector_type(4)));
typedef short v4i16_t __attribute__((ext_vector_type(4)));
typedef float f32x16 __attribute__((ext_vector_type(16)));
typedef float f32x4 __attribute__((ext_vector_type(4)));
typedef unsigned u32x4 __attribute__((ext_vector_type(4)));
typedef unsigned u32x2 __attribute__((ext_vector_type(2)));
typedef float f32x2_t __attribute__((ext_vector_type(2)));
typedef __bf16 bf16x2_t __attribute__((ext_vector_type(2)));
typedef LAS unsigned char* lp;
#define MFMA32(a, b, c) __builtin_amdgcn_mfma_f32_32x32x16_bf16((a), (b), (c), 0, 0, 0)
constexpr float NEGBIG = -1.0e30f;

DI int crow(int r, int h) { return (r & 3) + 8 * (r >> 2) + 4 * h; }
constexpr int PP = 256;
DI size_t pcol(int c) { return (size_t)(c >> 8) * ((size_t)MTOK * 256) + (size_t)(c & 255); }
DI unsigned cvtpk(float lo, float hi) { f32x2_t v = {lo, hi}; bf16x2_t b = __builtin_convertvector(v, bf16x2_t); return __builtin_bit_cast(unsigned, b); }
template <int S> DI bf16x8 pack8(const f32x16& x) {
    u32x4 p; p.x = cvtpk(x[8 * S], x[8 * S + 1]); p.y = cvtpk(x[8 * S + 2], x[8 * S + 3]); p.z = cvtpk(x[8 * S + 4], x[8 * S + 5]); p.w = cvtpk(x[8 * S + 6], x[8 * S + 7]);
    return __builtin_bit_cast(bf16x8, p);
}
DI s16x4 trd(lp p) { return __builtin_bit_cast(s16x4, __builtin_amdgcn_ds_read_tr16_b64_v4i16((LAS v4i16_t*)p)); }
template <int HI> DI bf16x8 vfrag(lp p) { const s16x4 lo = trd(p), hi = trd(p + HI); return __builtin_shufflevector(lo, hi, 0, 1, 2, 3, 4, 5, 6, 7); }
DI f32x16 zero16() { f32x16 z;
#pragma unroll
    for (int i = 0; i < 16; ++i) z[i] = 0.f; return z; }
DI float hmax16(const f32x16& p) { float a = fmaxf(fmaxf(p[0], p[1]), fmaxf(p[2], p[3]));
#pragma unroll
    for (int i = 4; i < 16; i += 4) a = fmaxf(a, fmaxf(fmaxf(p[i], p[i + 1]), fmaxf(p[i + 2], p[i + 3]))); return a; }
DI float hsum16(const f32x16& p) { float a = (p[0] + p[1]) + (p[2] + p[3]);
#pragma unroll
    for (int i = 4; i < 16; i += 4) a += (p[i] + p[i + 1]) + (p[i + 2] + p[i + 3]); return a; }

constexpr float SB_STOP = 26.0f;
DI void sb_unit(int b, int hs, int qb, const bf16_t* proj, bf16_t* obuf, lp lds) {
    constexpr int KS = 144, KBUF = 64 * KS, VBUF = 64 * 128, VOFF = 2 * KBUF, FOFF = VOFF + 2 * VBUF;
    int tid_ = threadIdx.x; asm volatile("" : "+v"(tid_));
    const int tid = tid_, lane = tid & 63, r = lane & 31, h = lane >> 5, wid = __builtin_amdgcn_readfirstlane(tid >> 6);
    const size_t rowbase = (size_t)b * SEQ; const int q0 = qb * 256, q0w = q0 + wid * 32, myq = q0w + r;
    bf16x8 qf[4];
    { const bf16_t* Qp = proj + pcol(hs * 64) + (rowbase + myq) * PP + 8 * h;
#pragma unroll
      for (int s = 0; s < 4; ++s) qf[s] = *(const bf16x8*)(Qp + 16 * s); }
    const int srow = tid >> 3, sc = tid & 7, soff = srow * KS + sc * 16, svoff = (srow >> 3) * 1024 + (sc >> 2) * 512 + (srow & 7) * 64 + (sc & 3) * 16;
    const bf16_t* Kg = proj + pcol(512 + hs * 64) + (rowbase + srow) * PP + sc * 8;
    const bf16_t* Vg = proj + pcol(1024 + hs * 64) + (rowbase + srow) * PP + sc * 8;
    bf16x8 T0, T1, ONES;
#pragma unroll
    for (int j = 0; j < 8; ++j) { const int k0 = 8 * (j >> 2) + 4 * h + (j & 3); T0[j] = (k0 >= r) ? (short)0x3F80 : (short)0; T1[j] = (16 + k0 >= r) ? (short)0x3F80 : (short)0; ONES[j] = (short)0x3F80; }
    f32x16 O0 = zero16(), O1 = zero16(); float carry = 0.f; bool wdone = false;
    const int NT = (q0 + 256) / 64;
    LAS unsigned* flags = (LAS unsigned*)(lds + FOFF);
    const int vlane = (4 * h + ((lane & 15) >> 2)) * 64 + ((lane >> 4) & 1) * 32 + (lane & 3) * 8;
    u32x4 kreg, vreg;
    int t = NT - 1;
    kreg = *(const u32x4*)(Kg + (size_t)(64 * t) * PP); vreg = *(const u32x4*)(Vg + (size_t)(64 * t) * PP);
    *(LAS u32x4*)(lds + soff) = kreg; *(LAS u32x4*)(lds + VOFF + svoff) = vreg;
    __syncthreads();
    asm volatile("" : "+v"(qf[0]), "+v"(qf[1]), "+v"(qf[2]), "+v"(qf[3]));
    int buf = 0;
    for (; t >= 0; --t) {
        if (t > 0) { kreg = *(const u32x4*)(Kg + (size_t)(64 * (t - 1)) * PP); vreg = *(const u32x4*)(Vg + (size_t)(64 * (t - 1)) * PP); }
        const int kvb = 64 * t;
        if (kvb <= q0w + 30 && !wdone) {
            const lp Kb = lds + buf * KBUF, Vb = lds + VOFF + buf * VBUF;
            f32x16 p0 = zero16(), p1 = zero16();
#pragma unroll
            for (int s = 0; s < 4; ++s) {
                const bf16x8 a0 = *(const LAS bf16x8*)(Kb + r * KS + s * 32 + h * 16), a1 = *(const LAS bf16x8*)(Kb + (32 + r) * KS + s * 32 + h * 16);
                p0 = MFMA32(a0, qf[s], p0); p1 = MFMA32(a1, qf[s], p1);
            }
            f32x16 sp0, sp1;
#pragma unroll
            for (int i = 0; i < 16; ++i) {
                const int kv = kvb + crow(i, h);
                { const float z = p0[i] * 0.125f, e = __builtin_amdgcn_exp2f(-fabsf(z) * LOG2E), sp = fmaxf(z, 0.f) + __builtin_amdgcn_logf(1.0f + e) * LN2; sp0[i] = (kv < myq) ? sp : 0.f; p0[i] = z; }
                { const float z = p1[i] * 0.125f, e = __builtin_amdgcn_exp2f(-fabsf(z) * LOG2E), sp = fmaxf(z, 0.f) + __builtin_amdgcn_logf(1.0f + e) * LN2; sp1[i] = (kv + 32 < myq) ? sp : 0.f; p1[i] = z; }
            }
            const bf16x8 sk0 = pack8<0>(sp0), sk1 = pack8<1>(sp0), sk2 = pack8<0>(sp1), sk3 = pack8<1>(sp1);
            f32x16 C0 = zero16(), C1 = zero16();
            C0 = MFMA32(T0, sk0, C0); C0 = MFMA32(T1, sk1, C0); C0 = MFMA32(ONES, sk2, C0); C0 = MFMA32(ONES, sk3, C0);
            C1 = MFMA32(T0, sk2, C1); C1 = MFMA32(T1, sk3, C1);
            const float tot = __shfl(C0[0], r);
#pragma unroll
            for (int i = 0; i < 16; ++i) {
                const int kv = kvb + crow(i, h);
                p0[i] = (kv < myq) ? __builtin_amdgcn_exp2f((p0[i] - C0[i] - carry) * LOG2E) : 0.f;
                p1[i] = (kv + 32 < myq) ? __builtin_amdgcn_exp2f((p1[i] - C1[i] - carry) * LOG2E) : 0.f;
            }
            carry += tot;
            const bf16x8 w0 = pack8<0>(p0), w1 = pack8<1>(p0), w2 = pack8<0>(p1), w3 = pack8<1>(p1);
            const lp vb = Vb + vlane;
            bf16x8 vf[8];
#pragma unroll
            for (int s = 0; s < 4; ++s) { vf[2 * s] = vfrag<1024>(vb + s * 2048); vf[2 * s + 1] = vfrag<1024>(vb + s * 2048 + 512); }
            __builtin_amdgcn_sched_barrier(0);
            O0 = MFMA32(vf[0], w0, O0); O1 = MFMA32(vf[1], w0, O1);
            O0 = MFMA32(vf[2], w1, O0); O1 = MFMA32(vf[3], w1, O1);
            O0 = MFMA32(vf[4], w2, O0); O1 = MFMA32(vf[5], w2, O1);
            O0 = MFMA32(vf[6], w3, O0); O1 = MFMA32(vf[7], w3, O1);
            wdone = __all(carry > SB_STOP) != 0;
        }
        if (t > 0) { *(LAS u32x4*)(lds + (buf ^ 1) * KBUF + soff) = kreg; *(LAS u32x4*)(lds + VOFF + (buf ^ 1) * VBUF + svoff) = vreg; }
        if (lane == 0) flags[(t & 1) * 8 + wid] = wdone ? 1u : 0u;
        __syncthreads();
        unsigned alld = 1u;
#pragma unroll
        for (int w = 0; w < 8; ++w) alld &= flags[(t & 1) * 8 + w];
        if (alld) break;
        buf ^= 1;
    }
    bf16_t* Op = obuf + (rowbase + myq) * DM + hs * 64 + 4 * h;
#pragma unroll
    for (int g = 0; g < 4; ++g) {
        u32x2 a; a.x = cvtpk(O0[4 * g], O0[4 * g + 1]); a.y = cvtpk(O0[4 * g + 2], O0[4 * g + 3]); *(u32x2*)(Op + 8 * g) = a;
        u32x2 c; c.x = cvtpk(O1[4 * g], O1[4 * g + 1]); c.y = cvtpk(O1[4 * g + 2], O1[4 * g + 3]); *(u32x2*)(Op + 32 + 8 * g) = c;
    }
    __syncthreads();
}

DI void diff_unit(int b, int hd, int qb, const bf16_t* proj, bf16_t* obuf, const float* lutg, float lam, const float* subg, lp lds, int ntcap = 1 << 30, int mode = 0) {
    constexpr int KS = 272, KBUF = 128 * KS, VBUF = 128 * 256, VOFF = 2 * KBUF, LOFF = VOFF + 2 * VBUF;
    int tid_ = threadIdx.x; asm volatile("" : "+v"(tid_));
    const int tid = tid_, lane = tid & 63, r = lane & 31, h = lane >> 5, wid = __builtin_amdgcn_readfirstlane(tid >> 6);
    const int map = wid >> 2, wq = wid & 3;
    const size_t rowbase = (size_t)b * SEQ; const int q0 = qb * 128, q0w = q0 + wq * 32, myq = q0w + r;
    LAS float* lutS = (LAS float*)(lds + LOFF);
    if (tid < 2 * LUTS) lutS[tid] = lutg[(8 + 2 * hd) * LUTS + tid];
    LAS float* subS = lutS + 2 * LUTS;
    if (tid >= 384 && tid < 512) subS[tid - 384] = subg[tid - 384];
    const LAS float* mylut = lutS + map * LUTS;
    bf16x8 qf[4];
    { const bf16_t* Qp = proj + pcol(1536 + hd * 128 + map * 64) + (rowbase + myq) * PP + 8 * h;
#pragma unroll
      for (int s = 0; s < 4; ++s) qf[s] = *(const bf16x8*)(Qp + 16 * s); }
    const int srow = tid >> 4, sc = tid & 15, soff = srow * KS + sc * 16, svoff = (srow >> 3) * 2048 + (sc >> 2) * 512 + (srow & 7) * 64 + (sc & 3) * 16;
    const unsigned toffK = (unsigned)(srow * PP + sc * 8), toffV = toffK + (unsigned)(pcol(2560 + hd * 128) - pcol(2048 + hd * 128));
    const bf16_t* const Kg = proj + pcol(2048 + hd * 128) + rowbase * PP;
    const int vlane = (4 * h + ((lane & 15) >> 2)) * 64 + ((lane >> 4) & 1) * 32 + (lane & 3) * 8;
    const float c2 = 0.125f * LOG2E;
    f32x16 O[4];
#pragma unroll
    for (int d = 0; d < 4; ++d) O[d] = zero16();
    float mrun = NEGBIG, lrun = 0.f;
    const int NT = min(qb + 1, ntcap);
#define DEXP(x) ((mode == 2) ? (x) : __builtin_amdgcn_exp2f(x))
#define DPV(A_, B_, C_) ((mode == 3) ? (C_) : MFMA32(A_, B_, C_))
    u32x4 kr[4];
#pragma unroll
    for (int j = 0; j < 4; ++j) kr[j] = *(const u32x4*)(Kg + (size_t)(32 * j) * PP + toffK);
#pragma unroll
    for (int j = 0; j < 4; ++j) *(LAS u32x4*)(lds + soff + 32 * j * KS) = kr[j];
#pragma unroll
    for (int j = 0; j < 4; ++j) kr[j] = *(const u32x4*)(Kg + (size_t)(32 * j) * PP + toffV);
#pragma unroll
    for (int j = 0; j < 4; ++j) *(LAS u32x4*)(lds + VOFF + svoff + 8192 * j) = kr[j];
    __syncthreads();
    asm volatile("" : "+v"(qf[0]), "+v"(qf[1]), "+v"(qf[2]), "+v"(qf[3]));
    int buf = 0;
#pragma unroll 1
    for (int t = 0; t < NT; ++t) {
        const size_t go = (size_t)(128 * (t + 1)) * PP;
        if (t + 1 < NT) {
#pragma unroll
            for (int j = 0; j < 4; ++j) kr[j] = *(const u32x4*)(Kg + go + (size_t)(32 * j) * PP + toffK); }
        if (mode == 1) {
            if (t + 1 < NT) {
#pragma unroll
                for (int j = 0; j < 4; ++j) *(LAS u32x4*)(lds + (buf ^ 1) * KBUF + soff + 32 * j * KS) = kr[j];
#pragma unroll
                for (int j = 0; j < 4; ++j) kr[j] = *(const u32x4*)(Kg + go + (size_t)(32 * j) * PP + toffV);
#pragma unroll
                for (int j = 0; j < 4; ++j) *(LAS u32x4*)(lds + VOFF + (buf ^ 1) * VBUF + svoff + 8192 * j) = kr[j]; }
            lrun = 1.0f;
        } else {
            const lp Kb0 = lds + buf * KBUF + map * 128 + r * KS + h * 16, Vb0 = lds + VOFF + buf * VBUF + vlane;
            const int kv0 = 128 * t;
            f32x16 a0, a1, b0, b1;
            bf16x8 w0, w1, w2, w3, x0, x1, x2, x3; float alpha0, alpha1;
#define DIFF_BIAS(P0, P1, KVB, SC, BI) do { \
            if ((KVB) + 63 + 128 <= q0w) { SC = c2; BI = mylut[128];     \
            } else { SC = 1.0f; BI = 0.0f; \
                _Pragma("unroll") for (int i = 0; i < 16; ++i) { \
                    const int d0_ = myq - ((KVB) + crow(i, h)), d1_ = d0_ - 32; \
                    const float l0_ = mylut[min(max(d0_, 0), 128)], l1_ = mylut[min(max(d1_, 0), 128)]; \
                    P0[i] = (d0_ >= 0) ? P0[i] * c2 + l0_ : NEGBIG; P1[i] = (d1_ >= 0) ? P1[i] * c2 + l1_ : NEGBIG; \
                    if ((i & 3) == 3) __builtin_amdgcn_sched_barrier(0); } } } while (0)
            __builtin_amdgcn_s_setprio(1);
            { bf16x8 k0[4];
#pragma unroll
              for (int s = 0; s < 4; ++s) k0[s] = *(const LAS bf16x8*)(Kb0 + s * 32);
              a0 = MFMA32(k0[0], qf[0], zero16());
#pragma unroll
              for (int s = 1; s < 4; ++s) a0 = MFMA32(k0[s], qf[s], a0);
              __builtin_amdgcn_sched_barrier(0);
#pragma unroll
              for (int s = 0; s < 4; ++s) k0[s] = *(const LAS bf16x8*)(Kb0 + 32 * KS + s * 32);
              a1 = MFMA32(k0[0], qf[0], zero16());
#pragma unroll
              for (int s = 1; s < 4; ++s) a1 = MFMA32(k0[s], qf[s], a1); }
            float sca, bia, scb, bib;
            __builtin_amdgcn_s_setprio(0);
            DIFF_BIAS(a0, a1, kv0, sca, bia);
            __builtin_amdgcn_sched_barrier(0);
            bf16x8 vr[4][2];
#define VOFFP(p) ((((p) >> 3) * 16384) + ((((p) & 7) >> 1) * 512) + (((p) & 1) * 8192))
#define VLOAD(p) do { vr[(p) & 3][0] = vfrag<2048>(Vb0 + VOFFP(p)); vr[(p) & 3][1] = vfrag<2048>(Vb0 + VOFFP(p) + 4096); } while (0)
            {
              bf16x8 k0[4];
#pragma unroll
              for (int s = 0; s < 4; ++s) k0[s] = *(const LAS bf16x8*)(Kb0 + 64 * KS + s * 32);
              b0 = MFMA32(k0[0], qf[0], zero16());
#pragma unroll
              for (int s = 1; s < 4; ++s) b0 = MFMA32(k0[s], qf[s], b0);
              float mx = fmaxf(hmax16(a0), hmax16(a1)); mx = fmaxf(mx, __shfl_xor(mx, 32));
              const float mnew = fmaxf(mrun, mx * sca + bia); alpha0 = __builtin_amdgcn_exp2f(mrun - mnew); const float offa = bia - mnew;
#pragma unroll
              for (int i = 0; i < 16; ++i) a0[i] = DEXP(a0[i] * sca + offa);
              w0 = pack8<0>(a0); w1 = pack8<1>(a0);
              const float s0 = hsum16(a0);
              __builtin_amdgcn_sched_barrier(0);
#pragma unroll
              for (int s = 0; s < 4; ++s) k0[s] = *(const LAS bf16x8*)(Kb0 + 96 * KS + s * 32);
              b1 = MFMA32(k0[0], qf[0], zero16());
#pragma unroll
              for (int s = 1; s < 4; ++s) b1 = MFMA32(k0[s], qf[s], b1);
#pragma unroll
              for (int i = 0; i < 16; ++i) a1[i] = DEXP(a1[i] * sca + offa);
              w2 = pack8<0>(a1); w3 = pack8<1>(a1);
              lrun = lrun * alpha0 + (s0 + hsum16(a1)); mrun = mnew; }
            __builtin_amdgcn_sched_barrier(0);
            VLOAD(0);
            if (__any(alpha0 != 1.0f)) {
#pragma unroll
                for (int d = 0; d < 4; ++d) O[d] = O[d] * alpha0; }
            if (t + 1 < NT) {
#pragma unroll
                for (int j = 0; j < 4; ++j) *(LAS u32x4*)(lds + (buf ^ 1) * KBUF + soff + 32 * j * KS) = kr[j];
#pragma unroll
                for (int j = 0; j < 4; ++j) kr[j] = *(const u32x4*)(Kg + go + (size_t)(32 * j) * PP + toffV); }
            DIFF_BIAS(b0, b1, kv0 + 64, scb, bib);
            __builtin_amdgcn_s_setprio(1);
            __builtin_amdgcn_sched_barrier(0);
            {
                float mx = fmaxf(hmax16(b0), hmax16(b1)); mx = fmaxf(mx, __shfl_xor(mx, 32));
                const float mnew1 = fmaxf(mrun, mx * scb + bib), off1 = bib - mnew1; alpha1 = __builtin_amdgcn_exp2f(mrun - mnew1);
                float sum1 = 0.f; unsigned xw[16];
                __builtin_amdgcn_sched_barrier(0);
#pragma unroll
                for (int j = 0; j < 16; ++j) {
                    if ((j & 1) == 0) VLOAD((j >> 1) + 1);
                    { const int i = j >> 1;
                      if (i & 1) O[i >> 1] = DPV(vr[i & 3][j & 1], (j & 1) ? w3 : w2, O[i >> 1]);
                      else       O[i >> 1] = DPV(vr[i & 3][j & 1], (j & 1) ? w1 : w0, O[i >> 1]); }
                    { float e0, e1;
                      if (j < 8) { e0 = DEXP(b0[2 * j] * scb + off1); e1 = DEXP(b0[2 * j + 1] * scb + off1); }
                      else       { e0 = DEXP(b1[2 * (j - 8)] * scb + off1); e1 = DEXP(b1[2 * (j - 8) + 1] * scb + off1); }
                      sum1 += e0 + e1; xw[j] = cvtpk(e0, e1);
                      asm volatile("" : "+v"(xw[j]), "+v"(sum1)); }
                    __builtin_amdgcn_sched_barrier(0);
                }
                { u32x4 t0 = {xw[0], xw[1], xw[2], xw[3]}, t1 = {xw[4], xw[5], xw[6], xw[7]}, t2 = {xw[8], xw[9], xw[10], xw[11]}, t3 = {xw[12], xw[13], xw[14], xw[15]};
                  x0 = __builtin_bit_cast(bf16x8, t0); x1 = __builtin_bit_cast(bf16x8, t1); x2 = __builtin_bit_cast(bf16x8, t2); x3 = __builtin_bit_cast(bf16x8, t3); }
                lrun = lrun * alpha1 + sum1; mrun = mnew1; }
            if (__any(alpha1 != 1.0f)) {
#pragma unroll
                for (int d = 0; d < 4; ++d) O[d] = O[d] * alpha1; }
            VLOAD(9); VLOAD(10);
#pragma unroll
            for (int i = 0; i < 8; ++i) {
                if (i < 5) VLOAD(8 + i + 3);
                if (i & 1) { O[i >> 1] = DPV(vr[i & 3][0], x2, O[i >> 1]); O[i >> 1] = DPV(vr[i & 3][1], x3, O[i >> 1]); }
                else       { O[i >> 1] = DPV(vr[i & 3][0], x0, O[i >> 1]); O[i >> 1] = DPV(vr[i & 3][1], x1, O[i >> 1]); }
                __builtin_amdgcn_sched_barrier(0);
            }
            __builtin_amdgcn_s_setprio(0);
#undef VLOAD
#undef VOFFP
            if (t + 1 < NT) {
#pragma unroll
                for (int j = 0; j < 4; ++j) *(LAS u32x4*)(lds + VOFF + (buf ^ 1) * VBUF + svoff + 8192 * j) = kr[j]; }
#undef DIFF_BIAS
        }
        __syncthreads();
        buf ^= 1;
    }
#undef DEXP
#undef DPV
    lrun += __shfl_xor(lrun, 32);
    const float inv = 1.0f / lrun;
    LAS float* X = (LAS float*)lds;
    if (map == 1) {
#pragma unroll
        for (int d = 0; d < 4; ++d)
#pragma unroll
            for (int i = 0; i < 16; ++i) X[(wq * 64 + d * 16 + i) * 64 + lane] = O[d][i] * inv;
    }
    __syncthreads();
    if (map == 0) {
        float ssq = 0.f;
#pragma unroll
        for (int d = 0; d < 4; ++d)
#pragma unroll
            for (int i = 0; i < 16; ++i) { const float v = O[d][i] * inv - lam * X[(wq * 64 + d * 16 + i) * 64 + lane]; O[d][i] = v; ssq += v * v; }
        ssq += __shfl_xor(ssq, 32);
        const float rn = __builtin_amdgcn_rsqf(ssq * (1.0f / 128.0f) + 1e-5f) * 0.8f;
        const lp stg = lds + VOFF + (wq * 32 + r) * 272 + 8 * h;
#pragma unroll
        for (int d = 0; d < 4; ++d)
#pragma unroll
            for (int g = 0; g < 4; ++g) {
                const f32x4 gv = *(const LAS f32x4*)(subS + 32 * d + 8 * g + 4 * h);
                u32x2 a; a.x = cvtpk(O[d][4 * g] * rn * gv[0], O[d][4 * g + 1] * rn * gv[1]); a.y = cvtpk(O[d][4 * g + 2] * rn * gv[2], O[d][4 * g + 3] * rn * gv[3]);
                *(LAS u32x2*)(stg + (32 * d + 8 * g) * 2) = a;
            }
    }
    __syncthreads();
    { bf16_t* Ob = obuf + (rowbase + q0) * DM + 512 + hd * 128;
#pragma unroll
      for (int i = 0; i < 4; ++i) { const int p = wid * 64 + lane + 512 * i, row = p >> 4, c = p & 15;
          const u32x4 v = *(const LAS u32x4*)(lds + VOFF + row * 272 + c * 16);
          *(u32x4*)(Ob + (size_t)row * DM + c * 8) = v; } }
    __syncthreads();
}

struct DilState { f32x16 O0, O1; float m, l; bf16x8 qf[4]; };
constexpr int DKS = 144, DCH = 256 * DKS, DVB = 256 * 128, DVOFF = 2 * DCH, DLOFF = DVOFF + 2 * DVB;
constexpr int DL_OWN = 192, DL_OTH = 384;
DI void dil_pv(DilState& st, const f32x16& p, float alpha, const bf16x8 (&vf)[4]) {
    if (__any(alpha != 1.0f)) { st.O0 = st.O0 * alpha; st.O1 = st.O1 * alpha; }
    const bf16x8 w0 = pack8<0>(p), w1 = pack8<1>(p);
    st.O0 = MFMA32(vf[0], w0, st.O0); st.O1 = MFMA32(vf[1], w0, st.O1);
    st.O0 = MFMA32(vf[2], w1, st.O0); st.O1 = MFMA32(vf[3], w1, st.O1);
}
DI f32x16 dil_qk(const DilState& st, lp kb, lp vb, bf16x8 (&vf)[4]) {
    bf16x8 ka[4];
#pragma unroll
    for (int s = 0; s < 4; ++s) ka[s] = *(const LAS bf16x8*)(kb + s * 32);
    vf[0] = vfrag<1024>(vb); vf[1] = vfrag<1024>(vb + 512); vf[2] = vfrag<1024>(vb + 2048); vf[3] = vfrag<1024>(vb + 2048 + 512);
    __builtin_amdgcn_sched_barrier(0);
    f32x16 p = zero16();
#pragma unroll
    for (int s = 0; s < 4; ++s) p = MFMA32(ka[s], st.qf[s], p);
    return p;
}
DI void dil_tile_lut(DilState& st, lp kb, lp vb, const LAS float* lut, const int LSTEP  ) {
    bf16x8 vf[4];
    f32x16 p = dil_qk(st, kb, vb, vf);
    const float c2 = 0.125f * LOG2E;
#pragma unroll
    for (int i = 0; i < 16; ++i) { const int ci = (i & 3) + 8 * (i >> 2); p[i] = p[i] * c2 + lut[(27 - ci) * LSTEP]; }
    float mx = hmax16(p); mx = fmaxf(mx, __shfl_xor(mx, 32));
    const float mnew = fmaxf(st.m, mx), alpha = __builtin_amdgcn_exp2f(st.m - mnew);
#pragma unroll
    for (int i = 0; i < 16; ++i) p[i] = __builtin_amdgcn_exp2f(p[i] - mnew);
    st.l = st.l * alpha + hsum16(p); st.m = mnew;
    dil_pv(st, p, alpha, vf);
}
DI void dil_tile_far(DilState& st, lp kb, lp vb, float b31, bool edge, int r, int h, const float (&me)[4]) {
    bf16x8 vf[4];
    f32x16 p = dil_qk(st, kb, vb, vf);
    const float c2 = 0.125f * LOG2E;
    const int e = r & 3;
    float v[4];
#pragma unroll
    for (int g = 0; g < 4; ++g) { const float x = (p[4 * g] * me[0] + p[4 * g + 1] * me[1]) + (p[4 * g + 2] * me[2] + p[4 * g + 3] * me[3]); v[g] = x * c2 + b31;
        if (edge && r > e + 8 * g + 4 * h) v[g] = NEGBIG; }
    float mx = fmaxf(fmaxf(v[0], v[1]), fmaxf(v[2], v[3])); mx = fmaxf(mx, __shfl_xor(mx, 32));
    const float mnew = fmaxf(st.m, mx), alpha = __builtin_amdgcn_exp2f(st.m - mnew);
#pragma unroll
    for (int g = 0; g < 4; ++g) v[g] = __builtin_amdgcn_exp2f(v[g] - mnew);
    st.l = st.l * alpha + ((v[0] + v[1]) + (v[2] + v[3])); st.m = mnew;
#pragma unroll
    for (int g = 0; g < 4; ++g) { p[4 * g] = v[g] * me[0]; p[4 * g + 1] = v[g] * me[1]; p[4 * g + 2] = v[g] * me[2]; p[4 * g + 3] = v[g] * me[3]; }
    dil_pv(st, p, alpha, vf);
}
DI void dil_unit(int b, int head, int span, const bf16_t* proj, bf16_t* obuf, const float* lutg, lp lds) {
    int tid_ = threadIdx.x; asm volatile("" : "+v"(tid_));
    const int tid = tid_, lane = tid & 63, r = lane & 31, h = lane >> 5, wid = __builtin_amdgcn_readfirstlane(tid >> 6);
    const int pr = wid >> 2, c = wid & 3;
    const size_t rowbase = (size_t)b * SEQ; const int T0 = span * 512;
    LAS float* lutOwn = (LAS float*)(lds + DLOFF); LAS float* lutOth = lutOwn + DL_OWN;
    { const float* lg = lutg + head * LUTS;
      for (int i = tid; i < DL_OWN + DL_OTH; i += 512) {
          float val;
          if (i < DL_OWN) { const int d = 4 * (i - 31); const int mult = (d <= 128 ? 1 : 0) + (d <= 512 ? 1 : 0) + ((d & 15) == 0 ? 1 : 0);
              val = (d < 0 || mult == 0) ? NEGBIG : lg[min(d, 128)] + ((mult == 3) ? 1.5849625007211562f : ((mult == 2) ? 1.0f : 0.0f)); }
          else { const int d = (i - DL_OWN) - 127; val = (d >= 0 && d <= 128) ? lg[d] : NEGBIG; }
          lutOwn[i] = val; } }
    float b31 = lutg[head * LUTS + 128];
    float me[4];
#pragma unroll
    for (int e = 0; e < 4; ++e) me[e] = ((r & 3) == e) ? 1.0f : 0.0f;
    DilState st[2];
#pragma unroll
    for (int q = 0; q < 2; ++q) { st[q].O0 = zero16(); st[q].O1 = zero16(); st[q].m = NEGBIG; st[q].l = 0.f;
        const bf16_t* Qp = proj + pcol(head * 64) + (rowbase + T0 + 128 * (2 * pr + q) + c + 4 * r) * PP + 8 * h;
#pragma unroll
        for (int s = 0; s < 4; ++s) st[q].qf[s] = *(const bf16x8*)(Qp + 16 * s); }
    const int x0 = tid >> 3, sc = tid & 7;
    const int rho0 = (x0 & 3) * 32 + (x0 >> 2), soff = rho0 * DKS + sc * 16;
    const int svoff = (rho0 >> 3) * 1024 + (sc >> 2) * 512 + (rho0 & 7) * 64 + (sc & 3) * 16;
    const unsigned toffK = (unsigned)(x0 * PP + sc * 8), toffV = toffK + (unsigned)(4 * (size_t)MTOK * 256);
    const bf16_t* const ubase = proj + pcol(1024 + head * 64) + (rowbase + (size_t)T0) * PP - (size_t)2048 * PP;
    const int vlane = (4 * h + ((lane & 15) >> 2)) * 64 + ((lane >> 4) & 1) * 32 + (lane & 3) * 8;
    const int klane = r * DKS + h * 16;
    const int k0 = (T0 >= 2048) ? 0 : (2048 - T0) / 256, nk = 10 - k0;
    const int kst = max(k0, (10 - (2 * span) % 10) % 10);
#define DIL_K(i) (k0 + (kst - k0 + (i)) % nk)
    u32x4 kr[4];
    { const bf16_t* cb = ubase + (size_t)(256 * kst) * PP;
#pragma unroll
      for (int j = 0; j < 4; ++j) kr[j] = *(const u32x4*)(cb + (size_t)(64 * j) * PP + toffK);
#pragma unroll
      for (int j = 0; j < 4; ++j) { const int o = soff + ((j >> 1) * 128 + 16 * (j & 1)) * DKS; *(LAS u32x4*)(lds + o) = kr[j]; }
#pragma unroll
      for (int j = 0; j < 4; ++j) kr[j] = *(const u32x4*)(cb + (size_t)(64 * j) * PP + toffV);
#pragma unroll
      for (int j = 0; j < 4; ++j) *(LAS u32x4*)(lds + DVOFF + svoff + ((j >> 1) * 16 + 2 * (j & 1)) * 1024) = kr[j]; }
    __syncthreads();
    asm volatile("" : "+v"(b31), "+v"(me[0]), "+v"(me[1]), "+v"(me[2]), "+v"(me[3]));
#pragma unroll
    for (int q = 0; q < 2; ++q) asm volatile("" : "+v"(st[q].qf[0]), "+v"(st[q].qf[1]), "+v"(st[q].qf[2]), "+v"(st[q].qf[3]));
    int buf = 0;
#pragma unroll 1
    for (int ik = 0; ik < nk; ++ik) {
        const int k = DIL_K(ik);
        const bool more = ik + 1 < nk;
        const bf16_t* const cn = ubase + (size_t)(256 * DIL_K(ik + 1)) * PP;
        if (more) {
#pragma unroll
            for (int j = 0; j < 4; ++j) kr[j] = *(const u32x4*)(cn + (size_t)(64 * j) * PP + toffK); }
#pragma unroll 1
        for (int hc = 0; hc < 2; ++hc) {
            const lp Kh = lds + buf * DCH + hc * 128 * DKS + klane, Vh = lds + DVOFF + buf * DVB + hc * 16384 + vlane;
#pragma unroll
            for (int q = 0; q < 2; ++q) {
                const int ch = 2 * k + hc - (2 * pr + q);
                if (ch < 0 || ch > 16) continue;
                if (ch <= 11) { dil_tile_far(st[q], Kh + c * 32 * DKS, Vh + c * 4096, b31, ch == 0, r, h, me); }
                else {
                    const int delta = 2048 - 128 * ch;
                    dil_tile_lut(st[q], Kh + c * 32 * DKS, Vh + c * 4096, lutOwn + (delta / 4 + r + 4 - 4 * h), 1);
                    if (ch >= 15) {
#pragma unroll 1
                        for (int cc = 1; cc < 4; ++cc) { const int cls = (c + cc) & 3;
                            dil_tile_lut(st[q], Kh + cls * 32 * DKS, Vh + cls * 4096, lutOth + (delta + (c - cls) + 4 * r + 19 - 16 * h), 4); }
                    }
                }
            }
            if (more) {
#pragma unroll
                for (int j = 0; j < 4; ++j) {
                    if (hc == 0) *(LAS u32x4*)(lds + (buf ^ 1) * DCH + soff + ((j >> 1) * 128 + 16 * (j & 1)) * DKS) = kr[j];
                    else *(LAS u32x4*)(lds + DVOFF + (buf ^ 1) * DVB + svoff + ((j >> 1) * 16 + 2 * (j & 1)) * 1024) = kr[j]; }
                if (hc == 0) {
#pragma unroll
                    for (int j = 0; j < 4; ++j) kr[j] = *(const u32x4*)(cn + (size_t)(64 * j) * PP + toffV); }
            }
        }
        __syncthreads();
        buf ^= 1;
    }
#undef DIL_K
#pragma unroll
    for (int q = 0; q < 2; ++q) {
        float l = st[q].l; l += __shfl_xor(l, 32);
        const float inv = 1.0f / l;
        const lp stg = lds + (128 * (2 * pr + q) + c + 4 * r) * DKS + 8 * h;
#pragma unroll
        for (int g = 0; g < 4; ++g) {
            u32x2 a; a.x = cvtpk(st[q].O0[4 * g] * inv, st[q].O0[4 * g + 1] * inv); a.y = cvtpk(st[q].O0[4 * g + 2] * inv, st[q].O0[4 * g + 3] * inv); *(LAS u32x2*)(stg + 16 * g) = a;
            u32x2 e; e.x = cvtpk(st[q].O1[4 * g] * inv, st[q].O1[4 * g + 1] * inv); e.y = cvtpk(st[q].O1[4 * g + 2] * inv, st[q].O1[4 * g + 3] * inv); *(LAS u32x2*)(stg + 64 + 16 * g) = e;
        }
    }
    __syncthreads();
    { bf16_t* Ob = obuf + (rowbase + T0) * DM + head * 64;
#pragma unroll
      for (int i = 0; i < 8; ++i) { const int p = wid * 64 + lane + 512 * i, row = p >> 3, cc = p & 7;
          const u32x4 v = *(const LAS u32x4*)(lds + row * DKS + cc * 16);
          *(u32x4*)(Ob + (size_t)row * DM + cc * 8) = v; } }
    __syncthreads();
}
}
#ifndef REP_DIFF
#define REP_DIFF 1
#endif
#ifndef REP_SB
#define REP_SB 1
#endif
#ifndef REP_PRO
#define REP_PRO 1
#endif
#ifndef REP_G
#define REP_G 1
#endif
#ifndef REP_SYNC
#define REP_SYNC 0
#endif
#ifndef REP_DIL
#define REP_DIL 1
#endif
#ifndef PHMASK
#define PHMASK 255
#endif
constexpr size_t MiB = (size_t)1 << 20;
constexpr size_t WS_SS = 0;
constexpr size_t WS_LUT = 2 * MiB, WS_BAR = 3 * MiB;
constexpr size_t WS_WINE = 4 * MiB, WS_WOUTE = 10 * MiB, WS_WINO = 12 * MiB, WS_WOUTO = 18 * MiB, WS_WUP = 20 * MiB, WS_WDN = 36 * MiB, WS_WG = 52 * MiB, WS_WPP = 56 * MiB;
constexpr size_t WS_HBA = 64 * MiB, WS_HBB = 192 * MiB;
constexpr size_t WS_PB = 320 * MiB;
constexpr size_t WS_BIG = 384 * MiB;
constexpr size_t WS_END = 896 * MiB;
constexpr int LDS_BYTES = 163840;
typedef unsigned short bf16;
typedef unsigned v4u __attribute__((ext_vector_type(4)));
typedef float f32x4 __attribute__((ext_vector_type(4)));

__device__ __forceinline__ unsigned f2bf(float f) { unsigned u = __builtin_bit_cast(unsigned, f); return (u + 0x7fffu + ((u >> 16) & 1u)) >> 16; }
__device__ __forceinline__ unsigned pk2(float lo, float hi) { return f2bf(lo) | (f2bf(hi) << 16); }
__device__ __forceinline__ float wave_sum(float v) {
#pragma unroll
    for (int o = 1; o < 64; o <<= 1) v += __shfl_xor(v, o);
    return v;
}
__device__ __forceinline__ void transpose_item(const float* W, int K, int N, bf16* WT, const float* g, LAS float* scr, int item, int lane) {
    const int nblk = N / 32, kb = item / nblk, nb = item % nblk, k0 = 64 * kb, n0 = 32 * nb;
#pragma unroll 8
    for (int i = 0; i < 32; ++i) { const int kk = 2 * i + (lane >> 5); scr[kk * 33 + (lane & 31)] = W[(size_t)(k0 + kk) * N + n0 + (lane & 31)]; }
    asm volatile("s_waitcnt lgkmcnt(0)" ::: "memory");
    const int c = lane & 7;
    float gs[8];
#pragma unroll
    for (int e = 0; e < 8; ++e) gs[e] = g ? g[k0 + 8 * c + e] : 1.0f;
#pragma unroll
    for (int j = 0; j < 4; ++j) { const int n = (lane >> 3) + 8 * j; const LAS float* s = scr + (8 * c) * 33 + n;
        v4u o; o.x = pk2(s[0 * 33] * gs[0], s[1 * 33] * gs[1]); o.y = pk2(s[2 * 33] * gs[2], s[3 * 33] * gs[3]); o.z = pk2(s[4 * 33] * gs[4], s[5 * 33] * gs[5]); o.w = pk2(s[6 * 33] * gs[6], s[7 * 33] * gs[7]);
        *(v4u*)(WT + (size_t)(n0 + n) * K + k0 + 8 * c) = o; }
    asm volatile("s_waitcnt lgkmcnt(0)" ::: "memory");
}
__device__ __forceinline__ int t5_bucket(int n) {
    if (n < 16) return n;
    const float v = logf((float)n / 16.0f) / 2.0794415416798357f * 16.0f;
    int l = 16 + (int)v; return l < 31 ? l : 31;
}

#define XB_TMO      128
#define XB_XCNT(j)  (256  + 64 * (j))
#define XB_XSUB(j)  (1280 + 64 * (j))
#define XB_XGEN(j)  (2304 + 64 * (j))
#define XB_TOP      3328
#define XB_TOPGEN   3392
#define XCD_BAR_WORDS 3456
#define XB_SPIN_CAP (1u << 18)

__device__ __forceinline__ unsigned xb_ld(unsigned* p)              { return __hip_atomic_load(p, __ATOMIC_RELAXED, __HIP_MEMORY_SCOPE_AGENT); }
__device__ __forceinline__ unsigned xb_add(unsigned* p, unsigned v) { return __hip_atomic_fetch_add(p, v, __ATOMIC_RELAXED, __HIP_MEMORY_SCOPE_AGENT); }
__device__ __forceinline__ unsigned xb_xcc_id() { return (unsigned)__builtin_amdgcn_s_getreg((3 << 11) | 20) & 0xFu; }
#define XB_SPIN(cond, bar) do { unsigned _sp = 0; while (cond) { __builtin_amdgcn_s_sleep(1); \
    if ((++_sp & 255u) == 0u) { if (xb_ld(&(bar)[XB_TMO])) break; if (_sp > XB_SPIN_CAP) { atomicAdd(&(bar)[XB_TMO], 1u); break; } } } } while (0)

struct XcdBarrier {
    unsigned* bar; unsigned x;
    volatile LAS unsigned* st;
};

__device__ __forceinline__ XcdBarrier xcd_barrier_post(unsigned* bar, volatile LAS unsigned* st) {
    XcdBarrier b; b.bar = bar; b.x = xb_xcc_id(); b.st = st;
    if (threadIdx.x == 0) (void)xb_add(&bar[XB_XCNT(b.x)], 1u);
    return b;
}
__device__ __forceinline__ void xcd_barrier_complete(unsigned* bar, unsigned x, unsigned& nloc, unsigned& nx) {
    const unsigned G = gridDim.x * gridDim.y * gridDim.z;
    unsigned sum, cnt, mine, sp = 0u;
    for (;;) {
        sum = 0u; cnt = 0u; mine = 0u;
#pragma unroll
        for (unsigned j = 0; j < 16; ++j) { const unsigned c = xb_ld(&bar[XB_XCNT(j)]); sum += c; cnt += (c > 0u) ? 1u : 0u; mine = (j == x) ? c : mine; }
        if (sum == G) break;
        __builtin_amdgcn_s_sleep(1);
        if ((++sp & 255u) == 0u) { if (xb_ld(&bar[XB_TMO])) break; if (sp > XB_SPIN_CAP) { atomicAdd(&bar[XB_TMO], 1u); break; } }
    }
    nloc = mine > 0u ? mine : 1u; nx = cnt > 0u ? cnt : 1u;
}

__device__ __forceinline__ void xcd_barrier(const XcdBarrier& b) {
    asm volatile("s_waitcnt vmcnt(0)" ::: "memory");
    __syncthreads();
    if (threadIdx.x == 0) {
        unsigned* bar = b.bar;
        __builtin_amdgcn_s_waitcnt(0);
        unsigned nloc = b.st[0], nx = b.st[1];
        if (nloc == 0u) { xcd_barrier_complete(bar, b.x, nloc, nx); b.st[0] = nloc; b.st[1] = nx; }
        const unsigned old = xb_add(&bar[XB_XSUB(b.x)], 1u);
        const unsigned gen = old / nloc;
        if (old + 1u == (gen + 1u) * nloc) {
            __builtin_amdgcn_fence(__ATOMIC_RELEASE, "agent");
            asm volatile("s_waitcnt vmcnt(0)" ::: "memory");
            const unsigned og = xb_add(&bar[XB_TOP], 1u);
            const unsigned tg = og / nx;
            if (og + 1u == (tg + 1u) * nx) xb_add(&bar[XB_TOPGEN], 1u);
            else XB_SPIN(xb_ld(&bar[XB_TOPGEN]) == tg, bar);
            __builtin_amdgcn_fence(__ATOMIC_ACQUIRE, "agent");
            xb_add(&bar[XB_XGEN(b.x)], 1u);
            asm volatile("s_waitcnt vmcnt(0)" ::: "memory");
        } else {
            XB_SPIN(xb_ld(&bar[XB_XGEN(b.x)]) == gen, bar);
            __builtin_amdgcn_fence(__ATOMIC_ACQUIRE, "agent");
            asm volatile("s_waitcnt vmcnt(0)" ::: "memory");
        }
    }
    __syncthreads();
}

struct Args { const float* in[20]; float* out; unsigned char* ws; };
enum { I_X = 0, I_P, I_T5, I_WINE, I_WOUTE, I_LQ1, I_LK1, I_LQ2, I_LK2, I_SUBG, I_WINO, I_WOUTO, I_GMIX, I_GMLP, I_WUP, I_WDN, I_GPLE, I_WG, I_WPP, I_GFIN };

__global__ void __launch_bounds__(512, 2) trunk_fwd(Args a) {
    extern __shared__ __attribute__((aligned(16))) unsigned char lds_raw[];
    cg::grid_group grid = cg::this_grid();
    LAS unsigned char* lds = (LAS unsigned char*)lds_raw;
    int tidp = threadIdx.x; asm volatile("" : "+v"(tidp));
    const int tid = tidp;
    const int G = gridDim.x, bx = blockIdx.x;
    const int vcu = (G % 8 == 0) ? (bx % 8) * (G / 8) + bx / 8 : bx;
    unsigned char* ws = a.ws;
    volatile LAS unsigned* bst = (volatile LAS unsigned*)(lds + LDS_BYTES - 64);
    if (tid < 2) bst[tid] = 0u;
#define WSP ({ unsigned char* w_ = a.ws; asm volatile("" : "+s"(w_)); w_; })
#define ssb ((float*)(WSP + WS_SS))
#define lutg ((float*)(WSP + WS_LUT))
#define hbA ((bf16*)(WSP + WS_HBA))
#define hbB ((bf16*)(WSP + WS_HBB))
#define pb ((bf16*)(WSP + WS_PB))
#define proj ((bf16*)(WSP + WS_BIG))
#define obuf ((bf16*)(WSP + WS_BIG + 384 * MiB))
#define ubuf ((bf16*)(WSP + WS_BIG))
#define ppb ((bf16*)(WSP + WS_BIG))
    unsigned* barw = (unsigned*)(WSP + WS_BAR);
    float* out = a.out;

    for (int rep = 0; rep < REP_PRO; ++rep) {
        const int lane = tid & 63, wave = __builtin_amdgcn_readfirstlane(tid >> 6);
        LAS float* scr = (LAS float*)(lds + wave * 16384);
        const int gw = vcu * 8 + wave, NGW = G * 8;
#define TR_ITEMS(K, N) (((K) / 64) * ((N) / 32))
        for (int it = gw; it < 13568; it += NGW) {
            int rr = it;
            if (rr < TR_ITEMS(1024, 3072)) { transpose_item(a.in[I_WINE], 1024, 3072, (bf16*)(WSP + WS_WINE), a.in[I_GMIX], scr, rr, lane); continue; } rr -= TR_ITEMS(1024, 3072);
            if (rr < TR_ITEMS(1024, 1024)) { transpose_item(a.in[I_WOUTE], 1024, 1024, (bf16*)(WSP + WS_WOUTE), nullptr, scr, rr, lane); continue; } rr -= TR_ITEMS(1024, 1024);
            if (rr < TR_ITEMS(1024, 3072)) { transpose_item(a.in[I_WINO], 1024, 3072, (bf16*)(WSP + WS_WINO), a.in[I_GMIX] + 1024, scr, rr, lane); continue; } rr -= TR_ITEMS(1024, 3072);
            if (rr < TR_ITEMS(1024, 1024)) { transpose_item(a.in[I_WOUTO], 1024, 1024, (bf16*)(WSP + WS_WOUTO), nullptr, scr, rr, lane); continue; } rr -= TR_ITEMS(1024, 1024);
            if (rr < 2 * TR_ITEMS(1024, 4096)) { const int L = rr / TR_ITEMS(1024, 4096); rr -= L * TR_ITEMS(1024, 4096);
                transpose_item(a.in[I_WUP] + (size_t)L * 1024 * 4096, 1024, 4096, (bf16*)(WSP + WS_WUP) + (size_t)L * 1024 * 4096, a.in[I_GMLP] + L * 1024, scr, rr, lane); continue; } rr -= 2 * TR_ITEMS(1024, 4096);
            if (rr < 2 * TR_ITEMS(4096, 1024)) { const int L = rr / TR_ITEMS(4096, 1024); rr -= L * TR_ITEMS(4096, 1024);
                transpose_item(a.in[I_WDN] + (size_t)L * 1024 * 4096, 4096, 1024, (bf16*)(WSP + WS_WDN) + (size_t)L * 1024 * 4096, nullptr, scr, rr, lane); continue; } rr -= 2 * TR_ITEMS(4096, 1024);
            if (rr < 2 * TR_ITEMS(1024, 1024)) { const int L = rr / TR_ITEMS(1024, 1024); rr -= L * TR_ITEMS(1024, 1024);
                transpose_item(a.in[I_WG] + (size_t)L * 1024 * 1024, 1024, 1024, (bf16*)(WSP + WS_WG) + (size_t)L * 1024 * 1024, a.in[I_GPLE] + L * 1024, scr, rr, lane); continue; } rr -= 2 * TR_ITEMS(1024, 1024);
            { const int L = rr / TR_ITEMS(256, 1024); rr -= L * TR_ITEMS(256, 1024);
                transpose_item(a.in[I_WPP] + (size_t)L * 256 * 1024, 256, 1024, (bf16*)(WSP + WS_WPP) + (size_t)L * 256 * 1024, nullptr, scr, rr, lane); }
        }
        const float* x = a.in[I_X];
        for (int m = gw; m < MTOK; m += 4 * NGW) {
            f32x4 v[4][4]; float s[4];
#pragma unroll
            for (int q = 0; q < 4; ++q) { const int mm = m + q * NGW; if (mm < MTOK) { const f32x4* xr = (const f32x4*)(x + (size_t)mm * DM) + lane;
#pragma unroll
                for (int j = 0; j < 4; ++j) v[q][j] = xr[64 * j]; } }
#pragma unroll
            for (int q = 0; q < 4; ++q) { const int mm = m + q * NGW; if (mm < MTOK) { float t = 0.f;
#pragma unroll
                for (int j = 0; j < 4; ++j) t += (v[q][j].x * v[q][j].x + v[q][j].y * v[q][j].y) + (v[q][j].z * v[q][j].z + v[q][j].w * v[q][j].w);
                s[q] = wave_sum(t);
                unsigned long long* o8 = (unsigned long long*)(hbB + (size_t)mm * DM) + lane;
#pragma unroll
                for (int j = 0; j < 4; ++j) o8[64 * j] = (unsigned long long)pk2(v[q][j].x, v[q][j].y) | ((unsigned long long)pk2(v[q][j].z, v[q][j].w) << 32);
                if (lane == 0) ssb[mm] = s[q]; } }
        }
        { const f32x4* p4 = (const f32x4*)a.in[I_P]; unsigned long long* o8 = (unsigned long long*)pb;
          const size_t n4 = (size_t)2 * MTOK * PLED / 4, stride = (size_t)G * 512;
          for (size_t i = (size_t)bx * 512 + tid; i < n4; i += 4 * stride) { f32x4 v[4];
#pragma unroll
              for (int q = 0; q < 4; ++q) if (i + q * stride < n4) v[q] = p4[i + q * stride];
#pragma unroll
              for (int q = 0; q < 4; ++q) if (i + q * stride < n4) o8[i + q * stride] = (unsigned long long)pk2(v[q].x, v[q].y) | ((unsigned long long)pk2(v[q].z, v[q].w) << 32); } }
        { const size_t n = (size_t)6 * MTOK, stride = (size_t)G * 512; float* z = ssb + MTOK;
          for (size_t i = (size_t)bx * 512 + tid; i < n; i += stride) z[i] = 0.f; }
        if (bx == 0) for (int i = tid; i < XCD_BAR_WORDS; i += 512) barw[i] = 0u;
        if (bx == 0) { const float* tab = a.in[I_T5];
            for (int i = tid; i < 16 * 129; i += 512) { const int slot = i / 129, d = i % 129; lutg[slot * LUTS + d] = tab[t5_bucket(d) * 16 + slot] * LOG2E; } }
    }
    grid.sync();
    const XcdBarrier xbar = xcd_barrier_post(barw, bst);
#pragma unroll 1
    for (int i = 0; i < REP_SYNC; ++i) xcd_barrier(xbar);

    float lam;
    { float s1 = 0.f, s2 = 0.f;
      for (int i = 0; i < 64; ++i) { s1 += a.in[I_LQ1][i] * a.in[I_LK1][i]; s2 += a.in[I_LQ2][i] * a.in[I_LK2][i]; }
      lam = expf(s1) - expf(s2) + 0.2f; lam = __uint_as_float(__builtin_amdgcn_readfirstlane(__float_as_uint(lam))); }

#pragma unroll 1
    for (int L = 0; L < 2; ++L) {
        float* ss_in0 = ssb + (size_t)(3 * L) * MTOK;
        float* ss_a = ssb + (size_t)(3 * L + 1) * MTOK;
        float* ss_b = ssb + (size_t)(3 * L + 2) * MTOK;
        float* ss_c = ssb + (size_t)(3 * L + 3) * MTOK;
#if PHMASK & 1
#pragma unroll 1
        for (int rep = 0; rep < REP_G; ++rep)
        { pg8::Gemm g{hbB, (const bf16*)(WSP + (L == 0 ? WS_WINE : WS_WINO)), MTOK, NPROJ, DM}; pg8::StaticOrder S; S.init(MTOK, NPROJ, G, bx);
          pg8::EpiNormBf16<0, true> E{proj, MTOK, ss_in0};
          pg8::gemm_phase<pg8::EpiNormBf16<0, true>, pg8::StaticOrder, true, true>(lds, g, S, E); }
#endif
        xcd_barrier(xbar);
#if PHMASK & 2
        if (L == 0) {
#ifdef PROBE_UNIT_OVERHEAD
#ifndef PROBE_MODE
#define PROBE_MODE 0
#endif
            if (G == 256) { const int bh = vcu >> 3, sidx = vcu & 7;
#pragma unroll 1
                for (int i = 0; i < 8; ++i) { const int qb = 8 * i + ((sidx + i) & 7); att::diff_unit(bh >> 2, bh & 3, qb, proj, obuf, lutg, lam, a.in[I_SUBG], lds, PROBE_UNIT_OVERHEAD, PROBE_MODE); } }
#endif
            for (int rep = 0; rep < REP_DIFF; ++rep)
            if (G == 256) {
                const int bh = vcu >> 3, sidx = vcu & 7;
#pragma unroll 1
                for (int i = 0; i < 8; ++i) { const int qb = 8 * i + ((sidx + i) & 7);
                    att::diff_unit(bh >> 2, bh & 3, qb, proj, obuf, lutg, lam, a.in[I_SUBG], lds); }
            } else {
#pragma unroll 1
                for (int u = vcu; u < 2048; u += G) { const int bh = u & 31, qb = 63 - (u >> 5); att::diff_unit(bh >> 2, bh & 3, qb, proj, obuf, lutg, lam, a.in[I_SUBG], lds); }
            }
            for (int rep = 0; rep < REP_SB; ++rep)
#pragma unroll 1
            for (int u = vcu; u < 2048; u += G) { const int bh = u & 63, qb = u >> 6; att::sb_unit(bh >> 3, bh & 7, qb, proj, obuf, lds); }
        }
#endif
#if PHMASK & 4
        if (L == 1) {
            for (int rep = 0; rep < REP_DIL; ++rep)
#pragma unroll 1
            for (int i = 0; i * G + vcu < 2048; ++i) {
                int b, head, span;
                if (G == 256) { const int j = vcu & 31, combo = i * 16 + 2 * (vcu >> 5) + (j >> 4); b = combo >> 4; head = combo & 15; span = ((j & 15) + 4 * (i >> 1)) & 15; if ((i & 1) && span < 4) span = 3 - span; }
                else { const int u = i * G + vcu; span = u & 15; head = (u >> 4) & 15; b = u >> 8; }
                att::dil_unit(b, head, span, proj, obuf, lutg, lds);
            }
        }
#endif
        xcd_barrier(xbar);
#if PHMASK & 8
        { pg8::Gemm g{obuf, (const bf16*)(WSP + (L == 0 ? WS_WOUTE : WS_WOUTO)), MTOK, DM, DM}; pg8::StaticOrder S; S.init(MTOK, DM, G, bx);
          pg8::EpiResid<false> E{nullptr, hbB, hbA, ss_a};
          pg8::gemm_phase<pg8::EpiResid<false>, pg8::StaticOrder, true, true>(lds, g, S, E); }
#endif
        xcd_barrier(xbar);
#if PHMASK & 16
#pragma unroll 1
        for (int rep = 0; rep < REP_G; ++rep)
        { pg8::Gemm g{hbA, (const bf16*)(WSP + WS_WUP) + (size_t)L * DM * DFF, MTOK, DFF, DM}; pg8::StaticOrder S; S.init(MTOK, DFF, G, bx);
          pg8::EpiNormBf16<1> E{ubuf, DFF, ss_a};
          pg8::gemm_phase<pg8::EpiNormBf16<1>, pg8::StaticOrder, true, true>(lds, g, S, E); }
#endif
        xcd_barrier(xbar);
#if PHMASK & 32
        { pg8::Gemm g{ubuf, (const bf16*)(WSP + WS_WDN) + (size_t)L * DM * DFF, MTOK, DM, DFF}; pg8::StaticOrder S; S.init(MTOK, DM, G, bx);
          pg8::EpiResid<false> E{nullptr, hbA, hbA, ss_b};
          pg8::gemm_phase<pg8::EpiResid<false>, pg8::StaticOrder, true, true>(lds, g, S, E); }
#endif
        xcd_barrier(xbar);
#if PHMASK & 64
        { int kpp = PLED; asm volatile("" : "+s"(kpp)); pg8::Gemm g{pb + (size_t)L * MTOK * PLED, (const bf16*)(WSP + WS_WPP) + (size_t)L * PLED * DM, MTOK, DM, kpp}; pg8::StaticOrder S; S.init(MTOK, DM, G, bx);
          pg8::EpiNormBf16<0> E{ppb, DM, nullptr};
          pg8::gemm_phase<pg8::EpiNormBf16<0>, pg8::StaticOrder, true, true>(lds, g, S, E); }
#endif
#if PHMASK & 128
        { pg8::Gemm g{hbA, (const bf16*)(WSP + WS_WG) + (size_t)L * DM * DM, MTOK, DM, DM}; pg8::StaticOrder S; S.init(MTOK, DM, G, bx);
          pg8::EpiGate E{hbA, hbB, ss_c, ss_b, ppb};
          pg8::gemm_phase<pg8::EpiGate, pg8::StaticOrder, true, true>(lds, g, S, E); }
#endif
        xcd_barrier(xbar);
    }
    { int tidf = threadIdx.x; asm volatile("" : "+v"(tidf)); const int lane = tidf & 63, wave = __builtin_amdgcn_readfirstlane(tidf >> 6);
      const int gw = bx * 8 + wave, NGW = G * 8; const float* ss = ssb + (size_t)6 * MTOK; const f32x4* g4 = (const f32x4*)a.in[I_GFIN] + 2 * lane;
      f32x4 gv[4];
#pragma unroll
      for (int j = 0; j < 2; ++j) { gv[2 * j] = g4[128 * j]; gv[2 * j + 1] = g4[128 * j + 1]; }
      for (int m = gw; m < MTOK; m += 4 * NGW) {
          v4u w[4][2]; float rs[4];
#pragma unroll
          for (int q = 0; q < 4; ++q) { const int mm = m + q * NGW; if (mm < MTOK) { const v4u* hi = (const v4u*)(hbB + (size_t)mm * DM) + lane; w[q][0] = hi[0]; w[q][1] = hi[64]; rs[q] = ss[mm]; } }
#pragma unroll
          for (int q = 0; q < 4; ++q) { const int mm = m + q * NGW; if (mm < MTOK) { const float r = __builtin_amdgcn_rsqf(rs[q] * (1.0f / 1024.0f) + 1e-6f);
              f32x4* o = (f32x4*)(out + (size_t)mm * DM) + 2 * lane;
#pragma unroll
              for (int j = 0; j < 2; ++j) { f32x4 p0, p1; pg8::unpack8(w[q][j], p0, p1); o[128 * j] = p0 * r * gv[2 * j]; o[128 * j + 1] = p1 * r * gv[2 * j + 1]; } } }
      } }
}

#undef ssb
#undef lutg
#undef hbA
#undef hbB
#undef pb
#undef proj
#undef obuf
#undef ubuf
#undef ppb
extern "C" void kernel_launch(void* const* d_in, const int* in_sizes, int n_in, void* d_out, int out_size, void* d_ws, size_t ws_size, hipStream_t stream) {
    static int grid_blocks = 0;
    if (grid_blocks == 0) {
        if (n_in != 20 || in_sizes[0] != MTOK * DM || out_size != MTOK * DM || ws_size < WS_END) {
            fprintf(stderr, "kernel_launch: unexpected shapes (n_in %d, in0 %d, out %d, ws %zu); nothing launched\n", n_in, n_in > 0 ? in_sizes[0] : -1, out_size, ws_size); grid_blocks = -1; return; }
        int dev = 0, cus = 0, per_cu = 0;
        (void)hipGetDevice(&dev); (void)hipDeviceGetAttribute(&cus, hipDeviceAttributeMultiprocessorCount, dev);
        if (hipFuncSetAttribute((const void*)trunk_fwd, hipFuncAttributeMaxDynamicSharedMemorySize, LDS_BYTES) != hipSuccess) { fprintf(stderr, "kernel_launch: hipFuncSetAttribute failed\n"); grid_blocks = -1; return; }
        if (hipOccupancyMaxActiveBlocksPerMultiprocessor(&per_cu, (const void*)trunk_fwd, 512, LDS_BYTES) != hipSuccess || per_cu < 1) { fprintf(stderr, "kernel_launch: occupancy query says %d blocks per CU\n", per_cu); per_cu = 1; }
        (void)hipGetLastError();
        grid_blocks = cus * per_cu;
    }
    if (grid_blocks < 0) return;
    Args a{};
    for (int i = 0; i < 20; ++i) a.in[i] = (const float*)d_in[i];
    a.out = (float*)d_out; a.ws = (unsigned char*)d_ws;
    void* args[] = {&a};
    hipError_t e = hipLaunchCooperativeKernel((const void*)trunk_fwd, dim3(grid_blocks), dim3(512), args, LDS_BYTES, stream);
    if (e != hipSuccess) fprintf(stderr, "cooperative launch failed: %s (grid %d)\n", hipGetErrorString(e), grid_blocks);
}
```

```cpp
#include <hip/hip_runtime.h>
#include <hip/hip_cooperative_groups.h>
#include <cstdio>
#include <cstdint>
namespace cg = cooperative_groups;
namespace pg8 {
#define PG8_LAS __attribute__((address_space(3)))
typedef unsigned short bf16_t;
typedef short bf16x8 __attribute__((ext_vector_type(8)));
typedef float f32x4 __attribute__((ext_vector_type(4)));
typedef unsigned u32x4 __attribute__((ext_vector_type(4)));
constexpr int BM = 256, BK = 64, HALF = 128, HTB = HALF * BK * 2  , STAGE_BYTES = 8 * HTB, NXCD = 8, WGM = 8;

__host__ __device__ __forceinline__ int lds_byte(int r, int c) { const int st = (r >> 4) * 2 + (c >> 5), rr = r & 15, cc = c & 31, ob = rr * 64 + cc * 2; return st * 1024 + (ob ^ (((ob >> 9) & 1) << 5)); }
__host__ __device__ __forceinline__ void stage_rc(int b, int& R, int& C) { const int st = b / 1024, sb = b % 1024, swz = sb ^ (((sb >> 9) & 1) << 5); R = (st >> 1) * 16 + swz / 64; C = (st & 1) * 32 + (swz % 64) / 2; }
__host__ __device__ __forceinline__ int perm32(int rho) { const int n = rho >> 4, i = rho & 15; return 8 * (i >> 2) + 4 * n + (i & 3); }

struct Unit { int pm, pn; };
struct Gemm { const bf16_t* A; const bf16_t* Bt; int M, N, K; };

struct StaticOrder {
    int nM, nN, nwg, G, c;
    __host__ __device__ void init(int M, int N, int G_, int c_) { nM = M / BM; nN = N / BM; nwg = nM * nN; G = G_; c = c_; }
    __host__ __device__ bool next(int i, Unit& u) const {
        const long L = (long)i * G + c; if (L >= nwg) return false;
        int wgid = (int)L; { const int q = nwg / NXCD, r = nwg % NXCD, xcd = wgid % NXCD, off = wgid / NXCD; wgid = (xcd < r ? xcd * (q + 1) : r * (q + 1) + (xcd - r) * q) + off; }
        const int nig = WGM * nN, gid = wgid / nig, fm = gid * WGM, gsz = (nM - fm) < WGM ? (nM - fm) : WGM;
        u.pm = fm + ((wgid % nig) % gsz); u.pn = (wgid % nig) / gsz; return true;
    }
    __device__ __forceinline__ void a_ready(const Unit&) const {}
    __device__ __forceinline__ void done(const Unit&) const {}
};

__device__ __forceinline__ unsigned cvt_pk_bf16(float lo, float hi) { unsigned r; asm volatile("v_cvt_pk_bf16_f32 %0, %1, %2" : "=v"(r) : "v"(lo), "v"(hi)); return r; }
__device__ __forceinline__ float row_rstd(const float* ss, int row) { return __builtin_amdgcn_rsqf(ss[row] * (1.0f / 1024.0f) + 1e-6f); }
template <int ACT  , bool TILED = false  > struct EpiNormBf16 {
    static constexpr bool PERM = true, AFTER_DRAIN = false;
    bf16_t* O; int ldc; const float* ss;
    __device__ __forceinline__ void operator()(const f32x4 (&acc)[2][2][4][2], const Unit& u, int wr, int wc, int fr, int fq) const {
        const int row0 = u.pm * BM + wr * 64 + fr, col0 = u.pn * BM + wc * 32 + 8 * fq;
        float rsv[8];
#pragma unroll
        for (int i = 0; i < 8; ++i) rsv[i] = ss ? ss[row0 + (i >> 2) * HALF + (i & 3) * 16] : 1.0f;
#pragma unroll
        for (int i = 0; i < 8; ++i) rsv[i] = ss ? __builtin_amdgcn_rsqf(rsv[i] * (1.0f / 1024.0f) + 1e-6f) : 1.0f;
#pragma unroll
        for (int ai = 0; ai < 2; ++ai)
#pragma unroll
            for (int m = 0; m < 4; ++m) {
                const int row = row0 + ai * HALF + m * 16;
                const float rs = rsv[ai * 4 + m];
                bf16_t* rowp = TILED ? O + (size_t)u.pn * ((size_t)ldc * BM) + (size_t)row * BM + (col0 - u.pn * BM) : O + (size_t)row * ldc + col0;
#pragma unroll
                for (int bj = 0; bj < 2; ++bj) {
                    f32x4 v0 = acc[ai][bj][m][0] * rs, v1 = acc[ai][bj][m][1] * rs;
                    if (ACT == 1) {
#pragma unroll
                        for (int e = 0; e < 4; ++e) { const float a = fmaxf(v0[e], 0.f), b = fmaxf(v1[e], 0.f); v0[e] = a * a; v1[e] = b * b; }
                    }
                    u32x4 w; w.x = cvt_pk_bf16(v0[0], v0[1]); w.y = cvt_pk_bf16(v0[2], v0[3]); w.z = cvt_pk_bf16(v1[0], v1[1]); w.w = cvt_pk_bf16(v1[2], v1[3]);
                    *(u32x4*)(rowp + bj * HALF) = w;
                }
            }
    }
};
__device__ __forceinline__ void unpack8(const u32x4 pw, f32x4& p0, f32x4& p1) {
    p0[0] = __uint_as_float(pw.x << 16); p0[1] = __uint_as_float(pw.x & 0xffff0000u); p0[2] = __uint_as_float(pw.y << 16); p0[3] = __uint_as_float(pw.y & 0xffff0000u);
    p1[0] = __uint_as_float(pw.z << 16); p1[1] = __uint_as_float(pw.z & 0xffff0000u); p1[2] = __uint_as_float(pw.w << 16); p1[3] = __uint_as_float(pw.w & 0xffff0000u);
}
template <bool BASE_F32> struct EpiResid {
    static constexpr bool PERM = true, AFTER_DRAIN = false;
    const float* basef; const bf16_t* baseb; bf16_t* hb; float* ss_out;
    __device__ __forceinline__ void operator()(const f32x4 (&acc)[2][2][4][2], const Unit& u, int wr, int wc, int fr, int fq) const {
        const int row0 = u.pm * BM + wr * 64 + fr, col0 = u.pn * BM + wc * 32 + 8 * fq;
#pragma unroll
        for (int ai = 0; ai < 2; ++ai) {
            f32x4 bv[4][2][2];
#pragma unroll
            for (int m = 0; m < 4; ++m)
#pragma unroll
                for (int bj = 0; bj < 2; ++bj) {
                    const size_t off = (size_t)(row0 + ai * HALF + m * 16) * 1024 + col0 + bj * HALF;
                    if (BASE_F32) { bv[m][bj][0] = *(const f32x4*)(basef + off); bv[m][bj][1] = *(const f32x4*)(basef + off + 4); }
                    else { const u32x4 w = *(const u32x4*)(baseb + off); bv[m][bj][0] = __builtin_bit_cast(f32x4, w); }
                }
#pragma unroll
            for (int m = 0; m < 4; ++m) {
                const int row = row0 + ai * HALF + m * 16; float sq = 0.f;
#pragma unroll
                for (int bj = 0; bj < 2; ++bj) {
                    const size_t off = (size_t)row * 1024 + col0 + bj * HALF;
                    f32x4 b0, b1;
                    if (BASE_F32) { b0 = bv[m][bj][0]; b1 = bv[m][bj][1]; } else unpack8(__builtin_bit_cast(u32x4, bv[m][bj][0]), b0, b1);
                    const f32x4 v0 = acc[ai][bj][m][0] + b0, v1 = acc[ai][bj][m][1] + b1;
                    u32x4 w; w.x = cvt_pk_bf16(v0[0], v0[1]); w.y = cvt_pk_bf16(v0[2], v0[3]); w.z = cvt_pk_bf16(v1[0], v1[1]); w.w = cvt_pk_bf16(v1[2], v1[3]);
                    *(u32x4*)(hb + off) = w;
                    sq += (v0[0] * v0[0] + v0[1] * v0[1]) + (v0[2] * v0[2] + v0[3] * v0[3]) + (v1[0] * v1[0] + v1[1] * v1[1]) + (v1[2] * v1[2] + v1[3] * v1[3]);
                }
                sq += __shfl_xor(sq, 16); sq += __shfl_xor(sq, 32);
                if (fq == 0) unsafeAtomicAdd(ss_out + row, sq);
            }
        }
    }
};
struct EpiGate {
    static constexpr bool PERM = true, AFTER_DRAIN = false;
    const bf16_t* baseb; bf16_t* hb; float* ss_out; const float* ss_in; const bf16_t* pp;
    __device__ __forceinline__ void operator()(const f32x4 (&acc)[2][2][4][2], const Unit& u, int wr, int wc, int fr, int fq) const {
        const int row0 = u.pm * BM + wr * 64 + fr, col0 = u.pn * BM + wc * 32 + 8 * fq;
        float rsv[8];
#pragma unroll
        for (int i = 0; i < 8; ++i) rsv[i] = ss_in[row0 + (i >> 2) * HALF + (i & 3) * 16];
#pragma unroll
        for (int ai = 0; ai < 2; ++ai) {
            u32x4 bw[4][2], pw[4][2];
#pragma unroll
            for (int m = 0; m < 4; ++m)
#pragma unroll
                for (int bj = 0; bj < 2; ++bj) {
                    const size_t off = (size_t)(row0 + ai * HALF + m * 16) * 1024 + col0 + bj * HALF;
                    bw[m][bj] = *(const u32x4*)(baseb + off); pw[m][bj] = *(const u32x4*)(pp + off);
                }
#pragma unroll
            for (int m = 0; m < 4; ++m) {
                const int row = row0 + ai * HALF + m * 16; float sq = 0.f;
                const float rs = __builtin_amdgcn_rsqf(rsv[ai * 4 + m] * (1.0f / 1024.0f) + 1e-6f) * (-1.4426950408889634f);
#pragma unroll
                for (int bj = 0; bj < 2; ++bj) {
                    const size_t off = (size_t)row * 1024 + col0 + bj * HALF;
                    f32x4 p0, p1, b0, b1;
                    unpack8(pw[m][bj], p0, p1); unpack8(bw[m][bj], b0, b1);
                    f32x4 v0, v1;
#pragma unroll
                    for (int e = 0; e < 4; ++e) {
                        const float g0 = __builtin_amdgcn_rcpf(1.0f + __builtin_amdgcn_exp2f(acc[ai][bj][m][0][e] * rs));
                        const float g1 = __builtin_amdgcn_rcpf(1.0f + __builtin_amdgcn_exp2f(acc[ai][bj][m][1][e] * rs));
                        v0[e] = b0[e] + p0[e] * g0; v1[e] = b1[e] + p1[e] * g1;
                    }
                    u32x4 w; w.x = cvt_pk_bf16(v0[0], v0[1]); w.y = cvt_pk_bf16(v0[2], v0[3]); w.z = cvt_pk_bf16(v1[0], v1[1]); w.w = cvt_pk_bf16(v1[2], v1[3]); *(u32x4*)(hb + off) = w;
                    sq += (v0[0] * v0[0] + v0[1] * v0[1]) + (v0[2] * v0[2] + v0[3] * v0[3]) + (v1[0] * v1[0] + v1[1] * v1[1]) + (v1[2] * v1[2] + v1[3] * v1[3]);
                }
                sq += __shfl_xor(sq, 16); sq += __shfl_xor(sq, 32);
                if (fq == 0) unsafeAtomicAdd(ss_out + row, sq);
            }
        }
    }
};
template <class Epi, class Sched, bool ALIGN_EPI = false, bool SP2 = false>
__device__ __forceinline__ void gemm_phase(PG8_LAS unsigned char* lds, const Gemm g, const Sched& S, const Epi& E) {
    int tid_ = threadIdx.x; asm volatile("" : "+v"(tid_));
    const int tid = tid_, wid = __builtin_amdgcn_readfirstlane(tid >> 6), lane = tid & 63, wr = wid >> 2, wc = wid & 3, fr = lane & 15, fq = lane >> 4;
    const int K = g.K, nt = K / BK;
    unsigned voffA[2], voffB[2];
#pragma unroll
    for (int i = 0; i < 2; ++i) { int R, C; stage_rc(tid * 16 + i * 8192, R, C); const int Rb = Epi::PERM ? ((R & ~31) + perm32(R & 31)) : R;
        voffA[i] = (unsigned)(R * K + C) * 2u; voffB[i] = (unsigned)(Rb * K + C) * 2u; }
    const size_t kstep = (size_t)(BK * 2);
    const size_t hstep = (size_t)HALF * K * 2;
    const size_t tstep = 2 * hstep;
    const unsigned ldsw = (unsigned)wid * 1024u;
    const int aoff = lds_byte(wr * 64 + fr, fq * 8), boff = lds_byte(wc * 32 + fr, fq * 8);
#define PG8_SA(b, h) (((b) * 2 + (h)) * HTB)
#define PG8_SB(b, h) ((4 + (b) * 2 + (h)) * HTB)
#define PG8_STAGE(bufoff, gbase, voff) do { _Pragma("unroll") for (int _i = 0; _i < 2; ++_i) \
        __builtin_amdgcn_global_load_lds((const unsigned*)((const char*)(gbase) + (voff)[_i]), (PG8_LAS unsigned*)(lds + (bufoff) + ldsw + _i * 8192), 16, 0, 0); } while (0)
#define PG8_LDA(dst, b, h) do { _Pragma("unroll") for (int m = 0; m < 4; ++m) _Pragma("unroll") for (int k = 0; k < 2; ++k) dst[m][k] = *(const PG8_LAS bf16x8*)(lds + PG8_SA(b, h) + aoff + m * 2048 + k * 1024); } while (0)
#define PG8_LDB(dst, b, h) do { _Pragma("unroll") for (int n = 0; n < 2; ++n) _Pragma("unroll") for (int k = 0; k < 2; ++k) dst[n][k] = *(const PG8_LAS bf16x8*)(lds + PG8_SB(b, h) + boff + n * 2048 + k * 1024); } while (0)
#define PG8_MMA(ai, bj, At, Bt) do { __builtin_amdgcn_s_setprio(1); _Pragma("unroll") for (int m = 0; m < 4; ++m) _Pragma("unroll") for (int n = 0; n < 2; ++n) _Pragma("unroll") for (int k = 0; k < 2; ++k) \
        acc[ai][bj][m][n] = __builtin_amdgcn_mfma_f32_16x16x32_bf16(Bt[n][k], At[m][k], acc[ai][bj][m][n], 0, 0, 0); __builtin_amdgcn_s_setprio(0); } while (0)
#define PG8_WAIT_V(n) asm volatile("s_waitcnt vmcnt(" #n ")" ::: "memory")
#define PG8_WAIT_L(n) asm volatile("s_waitcnt lgkmcnt(" #n ")" ::: "memory")
#define PG8_BAR __builtin_amdgcn_s_barrier()
#define PG8_SCHED __builtin_amdgcn_sched_barrier(0)
    Unit cur, nxt; int ui = 0;
    if (!S.next(0, cur)) return;
    f32x4 acc[2][2][4][2];
#pragma unroll
    for (int a = 0; a < 2; ++a)
#pragma unroll
        for (int b = 0; b < 2; ++b)
#pragma unroll
            for (int m = 0; m < 4; ++m)
#pragma unroll
                for (int n = 0; n < 2; ++n) acc[a][b][m][n] = (f32x4){0.f, 0.f, 0.f, 0.f};
    bf16x8 At[4][2], B0[2][2], B1[2][2];
    const char* cA = (const char*)g.A + (size_t)cur.pm * tstep; const char* cB = (const char*)g.Bt + (size_t)cur.pn * tstep;
    S.a_ready(cur);
    if constexpr (SP2) {
        PG8_STAGE(PG8_SB(0, 0), cB, voffB); PG8_STAGE(PG8_SB(0, 1), cB + hstep, voffB); PG8_STAGE(PG8_SA(0, 0), cA, voffA); PG8_STAGE(PG8_SA(0, 1), cA + hstep, voffA);
        if (wr == 1) PG8_BAR;
        PG8_WAIT_V(2); PG8_BAR;
        PG8_STAGE(PG8_SB(1, 0), cB + kstep, voffB); PG8_STAGE(PG8_SA(1, 0), cA + kstep, voffA); PG8_STAGE(PG8_SB(1, 1), cB + hstep + kstep, voffB);
        PG8_WAIT_V(6); PG8_BAR;
    } else {
        PG8_STAGE(PG8_SB(0, 0), cB, voffB); PG8_STAGE(PG8_SA(0, 0), cA, voffA); PG8_STAGE(PG8_SB(0, 1), cB + hstep, voffB); PG8_STAGE(PG8_SA(0, 1), cA + hstep, voffA);
        if (wr == 1) PG8_BAR;
        PG8_WAIT_V(4); PG8_BAR;
        PG8_STAGE(PG8_SB(1, 0), cB + kstep, voffB); PG8_STAGE(PG8_SA(1, 0), cA + kstep, voffA); PG8_STAGE(PG8_SB(1, 1), cB + hstep + kstep, voffB);
        PG8_WAIT_V(6); PG8_BAR;
    }
    for (;;) {
        const bool has_next = S.next(ui + 1, nxt);
        const char* nA = has_next ? (const char*)g.A + (size_t)nxt.pm * tstep : cA; const char* nB = has_next ? (const char*)g.Bt + (size_t)nxt.pn * tstep : cB;
        for (int t = 0; t < nt; t += 2) {
            const bool last = (t == nt - 2);
            const char* a1 = cA + (size_t)(t + 1) * kstep;
            const char* a2 = last ? nA : cA + (size_t)(t + 2) * kstep; const char* b2 = last ? nB : cB + (size_t)(t + 2) * kstep;
            const char* a3 = a2 + kstep; const char* b3 = b2 + kstep;
            if (last && has_next) S.a_ready(nxt);
            if constexpr (SP2) {
            PG8_LDB(B0, 0, 0); PG8_LDB(B1, 0, 1); PG8_SCHED; PG8_LDA(At, 0, 0); PG8_STAGE(PG8_SA(1, 1), a1 + hstep, voffA);
            PG8_WAIT_V(8); PG8_WAIT_L(0); PG8_BAR; PG8_MMA(0, 0, At, B0); PG8_MMA(0, 1, At, B1); PG8_BAR; PG8_SCHED;
            PG8_LDA(At, 0, 1); PG8_STAGE(PG8_SB(0, 0), b2, voffB); PG8_STAGE(PG8_SB(0, 1), b2 + hstep, voffB); PG8_STAGE(PG8_SA(0, 0), a2, voffA);
            PG8_WAIT_V(8); PG8_WAIT_L(0); PG8_BAR; PG8_MMA(1, 0, At, B0); PG8_MMA(1, 1, At, B1); PG8_BAR; PG8_SCHED;
            PG8_LDB(B0, 1, 0); PG8_LDB(B1, 1, 1); PG8_SCHED; PG8_LDA(At, 1, 0); PG8_STAGE(PG8_SA(0, 1), a2 + hstep, voffA);
            PG8_WAIT_V(8); PG8_WAIT_L(0); PG8_BAR; PG8_MMA(0, 0, At, B0); PG8_MMA(0, 1, At, B1); PG8_BAR; PG8_SCHED;
            PG8_LDA(At, 1, 1); PG8_STAGE(PG8_SB(1, 0), b3, voffB); PG8_STAGE(PG8_SB(1, 1), b3 + hstep, voffB); PG8_STAGE(PG8_SA(1, 0), a3, voffA);
            PG8_WAIT_V(8); PG8_WAIT_L(0); PG8_BAR; PG8_MMA(1, 0, At, B0); PG8_MMA(1, 1, At, B1); PG8_BAR; PG8_SCHED;
            } else {
            PG8_LDB(B0, 0, 0); PG8_SCHED; PG8_LDA(At, 0, 0); PG8_STAGE(PG8_SA(1, 1), a1 + hstep, voffA);
            PG8_WAIT_L(8); PG8_BAR; PG8_WAIT_L(0); PG8_MMA(0, 0, At, B0); PG8_BAR; PG8_SCHED;
            PG8_LDB(B1, 0, 1); PG8_STAGE(PG8_SB(0, 0), b2, voffB);
            PG8_BAR; PG8_WAIT_L(0); PG8_MMA(0, 1, At, B1); PG8_BAR;
            PG8_LDA(At, 0, 1); PG8_STAGE(PG8_SA(0, 0), a2, voffA);
            PG8_BAR; PG8_WAIT_L(0); PG8_MMA(1, 0, At, B0); PG8_BAR; PG8_SCHED;
            PG8_STAGE(PG8_SB(0, 1), b2 + hstep, voffB);
            PG8_WAIT_V(6); PG8_BAR; PG8_MMA(1, 1, At, B1); PG8_BAR;
            PG8_LDB(B0, 1, 0); PG8_SCHED; PG8_LDA(At, 1, 0); PG8_STAGE(PG8_SA(0, 1), a2 + hstep, voffA);
            PG8_WAIT_L(8); PG8_BAR; PG8_WAIT_L(0); PG8_MMA(0, 0, At, B0); PG8_BAR; PG8_SCHED;
            PG8_LDB(B1, 1, 1); PG8_STAGE(PG8_SB(1, 0), b3, voffB);
            PG8_BAR; PG8_WAIT_L(0); PG8_MMA(0, 1, At, B1); PG8_BAR;
            PG8_LDA(At, 1, 1); PG8_STAGE(PG8_SA(1, 0), a3, voffA);
            PG8_BAR; PG8_WAIT_L(0); PG8_MMA(1, 0, At, B0); PG8_BAR; PG8_SCHED;
            PG8_STAGE(PG8_SB(1, 1), b3 + hstep, voffB);
            PG8_WAIT_V(6); PG8_BAR; PG8_MMA(1, 1, At, B1); PG8_BAR;
            }
        }
        if constexpr (ALIGN_EPI) { if (wr == 0) PG8_BAR; }
        if constexpr (!Epi::AFTER_DRAIN) { E(acc, cur, wr, wc, fr, fq); S.done(cur); }
        if (!has_next) break;
#pragma unroll
        for (int a = 0; a < 2; ++a)
#pragma unroll
            for (int b = 0; b < 2; ++b)
#pragma unroll
                for (int m = 0; m < 4; ++m)
#pragma unroll
                    for (int n = 0; n < 2; ++n) acc[a][b][m][n] = (f32x4){0.f, 0.f, 0.f, 0.f};
        cur = nxt; cA = nA; cB = nB; ++ui;
        if constexpr (ALIGN_EPI) { if (wr == 1) PG8_BAR; }
    }
    PG8_WAIT_V(0);
    if constexpr (!ALIGN_EPI) { if (wr == 0) PG8_BAR; }
    PG8_BAR;
    if constexpr (Epi::AFTER_DRAIN) { E.fused(acc, cur, wr, wc, fr, fq, lds, wid, lane); S.done(cur); }
#undef PG8_SA
#undef PG8_SB
#undef PG8_STAGE
#undef PG8_LDA
#undef PG8_LDB
#undef PG8_MMA
#undef PG8_WAIT_V
#undef PG8_WAIT_L
#undef PG8_BAR
#undef PG8_SCHED
}
}
constexpr int NB = 8, SEQ = 8192, DM = 1024, MTOK = NB * SEQ, NPROJ = 3072, DFF = 4096, PLED = 256;
constexpr float LOG2E = 1.4426950408889634f, LN2 = 0.6931471805599453f;
constexpr int LUTS = 132;

namespace att {
#define LAS __attribute__((address_space(3)))
#define DI __device__ __forceinline__
typedef unsigned short bf16_t;
typedef short bf16x8 __attribute__((ext_vector_type(8)));
typedef short s16x4 __attribute__((ext_vector_type(4)));
typedef short v4i16_t __attribute__((ext_vector_type(4)));
typedef float f32x16 __attribute__((ext_vector_type(16)));
typedef float f32x4 __attribute__((ext_vector_type(4)));
typedef unsigned u32x4 __attribute__((ext_vector_type(4)));
typedef unsigned u32x2 __attribute__((ext_vector_type(2)));
typedef float f32x2_t __attribute__((ext_vector_type(2)));
typedef __bf16 bf16x2_t __attribute__((ext_vector_type(2)));
typedef LAS unsigned char* lp;
#define MFMA32(a, b, c) __builtin_amdgcn_mfma_f32_32x32x16_bf16((a), (b), (c), 0, 0, 0)
constexpr float NEGBIG = -1.0e30f;

DI int crow(int r, int h) { return (r & 3) + 8 * (r >> 2) + 4 * h; }
constexpr int PP = 256;
DI size_t pcol(int c) { return (size_t)(c >> 8) * ((size_t)MTOK * 256) + (size_t)(c & 255); }
DI unsigned cvtpk(float lo, float hi) { f32x2_t v = {lo, hi}; bf16x2_t b = __builtin_convertvector(v, bf16x2_t); return __builtin_bit_cast(unsigned, b); }
template <int S> DI bf16x8 pack8(const f32x16& x) {
    u32x4 p; p.x = cvtpk(x[8 * S], x[8 * S + 1]); p.y = cvtpk(x[8 * S + 2], x[8 * S + 3]); p.z = cvtpk(x[8 * S + 4], x[8 * S + 5]); p.w = cvtpk(x[8 * S + 6], x[8 * S + 7]);
    return __builtin_bit_cast(bf16x8, p);
}
DI s16x4 trd(lp p) { return __builtin_bit_cast(s16x4, __builtin_amdgcn_ds_read_tr16_b64_v4i16((LAS v4i16_t*)p)); }
template <int HI> DI bf16x8 vfrag(lp p) { const s16x4 lo = trd(p), hi = trd(p + HI); return __builtin_shufflevector(lo, hi, 0, 1, 2, 3, 4, 5, 6, 7); }
DI f32x16 zero16() { f32x16 z;
#pragma unroll
    for (int i = 0; i < 16; ++i) z[i] = 0.f; return z; }
DI float hmax16(const f32x16& p) { float a = fmaxf(fmaxf(p[0], p[1]), fmaxf(p[2], p[3]));
#pragma unroll
    for (int i = 4; i < 16; i += 4) a = fmaxf(a, fmaxf(fmaxf(p[i], p[i + 1]), fmaxf(p[i + 2], p[i + 3]))); return a; }
DI float hsum16(const f32x16& p) { float a = (p[0] + p[1]) + (p[2] + p[3]);
#pragma unroll
    for (int i = 4; i < 16; i += 4) a += (p[i] + p[i + 1]) + (p[i + 2] + p[i + 3]); return a; }

constexpr float SB_STOP = 26.0f;
DI void sb_unit(int b, int hs, int qb, const bf16_t* proj, bf16_t* obuf, lp lds) {
    constexpr int KS = 144, KBUF = 64 * KS, VBUF = 64 * 128, VOFF = 2 * KBUF, FOFF = VOFF + 2 * VBUF;
    int tid_ = threadIdx.x; asm volatile("" : "+v"(tid_));
    const int tid = tid_, lane = tid & 63, r = lane & 31, h = lane >> 5, wid = __builtin_amdgcn_readfirstlane(tid >> 6);
    const size_t rowbase = (size_t)b * SEQ; const int q0 = qb * 256, q0w = q0 + wid * 32, myq = q0w + r;
    bf16x8 qf[4];
    { const bf16_t* Qp = proj + pcol(hs * 64) + (rowbase + myq) * PP + 8 * h;
#pragma unroll
      for (int s = 0; s < 4; ++s) qf[s] = *(const bf16x8*)(Qp + 16 * s); }
    const int srow = tid >> 3, sc = tid & 7, soff = srow * KS + sc * 16, svoff = (srow >> 3) * 1024 + (sc >> 2) * 512 + (srow & 7) * 64 + (sc & 3) * 16;
    const bf16_t* Kg = proj + pcol(512 + hs * 64) + (rowbase + srow) * PP + sc * 8;
    const bf16_t* Vg = proj + pcol(1024 + hs * 64) + (rowbase + srow) * PP + sc * 8;
    bf16x8 T0, T1, ONES;
#pragma unroll
    for (int j = 0; j < 8; ++j) { const int k0 = 8 * (j >> 2) + 4 * h + (j & 3); T0[j] = (k0 >= r) ? (short)0x3F80 : (short)0; T1[j] = (16 + k0 >= r) ? (short)0x3F80 : (short)0; ONES[j] = (short)0x3F80; }
    f32x16 O0 = zero16(), O1 = zero16(); float carry = 0.f; bool wdone = false;
    const int NT = (q0 + 256) / 64;
    LAS unsigned* flags = (LAS unsigned*)(lds + FOFF);
    const int vlane = (4 * h + ((lane & 15) >> 2)) * 64 + ((lane >> 4) & 1) * 32 + (lane & 3) * 8;
    u32x4 kreg, vreg;
    int t = NT - 1;
    kreg = *(const u32x4*)(Kg + (size_t)(64 * t) * PP); vreg = *(const u32x4*)(Vg + (size_t)(64 * t) * PP);
    *(LAS u32x4*)(lds + soff) = kreg; *(LAS u32x4*)(lds + VOFF + svoff) = vreg;
    __syncthreads();
    asm volatile("" : "+v"(qf[0]), "+v"(qf[1]), "+v"(qf[2]), "+v"(qf[3]));
    int buf = 0;
    for (; t >= 0; --t) {
        if (t > 0) { kreg = *(const u32x4*)(Kg + (size_t)(64 * (t - 1)) * PP); vreg = *(const u32x4*)(Vg + (size_t)(64 * (t - 1)) * PP); }
        const int kvb = 64 * t;
        if (kvb <= q0w + 30 && !wdone) {
            const lp Kb = lds + buf * KBUF, Vb = lds + VOFF + buf * VBUF;
            f32x16 p0 = zero16(), p1 = zero16();
#pragma unroll
            for (int s = 0; s < 4; ++s) {
                const bf16x8 a0 = *(const LAS bf16x8*)(Kb + r * KS + s * 32 + h * 16), a1 = *(const LAS bf16x8*)(Kb + (32 + r) * KS + s * 32 + h * 16);
                p0 = MFMA32(a0, qf[s], p0); p1 = MFMA32(a1, qf[s], p1);
            }
            f32x16 sp0, sp1;
#pragma unroll
            for (int i = 0; i < 16; ++i) {
                const int kv = kvb + crow(i, h);
                { const float z = p0[i] * 0.125f, e = __builtin_amdgcn_exp2f(-fabsf(z) * LOG2E), sp = fmaxf(z, 0.f) + __builtin_amdgcn_logf(1.0f + e) * LN2; sp0[i] = (kv < myq) ? sp : 0.f; p0[i] = z; }
                { const float z = p1[i] * 0.125f, e = __builtin_amdgcn_exp2f(-fabsf(z) * LOG2E), sp = fmaxf(z, 0.f) + __builtin_amdgcn_logf(1.0f + e) * LN2; sp1[i] = (kv + 32 < myq) ? sp : 0.f; p1[i] = z; }
            }
            const bf16x8 sk0 = pack8<0>(sp0), sk1 = pack8<1>(sp0), sk2 = pack8<0>(sp1), sk3 = pack8<1>(sp1);
            f32x16 C0 = zero16(), C1 = zero16();
            C0 = MFMA32(T0, sk0, C0); C0 = MFMA32(T1, sk1, C0); C0 = MFMA32(ONES, sk2, C0); C0 = MFMA32(ONES, sk3, C0);
            C1 = MFMA32(T0, sk2, C1); C1 = MFMA32(T1, sk3, C1);
            const float tot = __shfl(C0[0], r);
#pragma unroll
            for (int i = 0; i < 16; ++i) {
                const int kv = kvb + crow(i, h);
                p0[i] = (kv < myq) ? __builtin_amdgcn_exp2f((p0[i] - C0[i] - carry) * LOG2E) : 0.f;
                p1[i] = (kv + 32 < myq) ? __builtin_amdgcn_exp2f((p1[i] - C1[i] - carry) * LOG2E) : 0.f;
            }
            carry += tot;
            const bf16x8 w0 = pack8<0>(p0), w1 = pack8<1>(p0), w2 = pack8<0>(p1), w3 = pack8<1>(p1);
            const lp vb = Vb + vlane;
            bf16x8 vf[8];
#pragma unroll
            for (int s = 0; s < 4; ++s) { vf[2 * s] = vfrag<1024>(vb + s * 2048); vf[2 * s + 1] = vfrag<1024>(vb + s * 2048 + 512); }
            __builtin_amdgcn_sched_barrier(0);
            O0 = MFMA32(vf[0], w0, O0); O1 = MFMA32(vf[1], w0, O1);
            O0 = MFMA32(vf[2], w1, O0); O1 = MFMA32(vf[3], w1, O1);
            O0 = MFMA32(vf[4], w2, O0); O1 = MFMA32(vf[5], w2, O1);
            O0 = MFMA32(vf[6], w3, O0); O1 = MFMA32(vf[7], w3, O1);
            wdone = __all(carry > SB_STOP) != 0;
        }
        if (t > 0) { *(LAS u32x4*)(lds + (buf ^ 1) * KBUF + soff) = kreg; *(LAS u32x4*)(lds + VOFF + (buf ^ 1) * VBUF + svoff) = vreg; }
        if (lane == 0) flags[(t & 1) * 8 + wid] = wdone ? 1u : 0u;
        __syncthreads();
        unsigned alld = 1u;
#pragma unroll
        for (int w = 0; w < 8; ++w) alld &= flags[(t & 1) * 8 + w];
        if (alld) break;
        buf ^= 1;
    }
    bf16_t* Op = obuf + (rowbase + myq) * DM + hs * 64 + 4 * h;
#pragma unroll
    for (int g = 0; g < 4; ++g) {
        u32x2 a; a.x = cvtpk(O0[4 * g], O0[4 * g + 1]); a.y = cvtpk(O0[4 * g + 2], O0[4 * g + 3]); *(u32x2*)(Op + 8 * g) = a;
        u32x2 c; c.x = cvtpk(O1[4 * g], O1[4 * g + 1]); c.y = cvtpk(O1[4 * g + 2], O1[4 * g + 3]); *(u32x2*)(Op + 32 + 8 * g) = c;
    }
    __syncthreads();
}

DI void diff_unit(int b, int hd, int qb, const bf16_t* proj, bf16_t* obuf, const float* lutg, float lam, const float* subg, lp lds, int ntcap = 1 << 30, int mode = 0) {
    constexpr int KS = 272, KBUF = 128 * KS, VBUF = 128 * 256, VOFF = 2 * KBUF, LOFF = VOFF + 2 * VBUF;
    int tid_ = threadIdx.x; asm volatile("" : "+v"(tid_));
    const int tid = tid_, lane = tid & 63, r = lane & 31, h = lane >> 5, wid = __builtin_amdgcn_readfirstlane(tid >> 6);
    const int map = wid >> 2, wq = wid & 3;
    const size_t rowbase = (size_t)b * SEQ; const int q0 = qb * 128, q0w = q0 + wq * 32, myq = q0w + r;
    LAS float* lutS = (LAS float*)(lds + LOFF);
    if (tid < 2 * LUTS) lutS[tid] = lutg[(8 + 2 * hd) * LUTS + tid];
    LAS float* subS = lutS + 2 * LUTS;
    if (tid >= 384 && tid < 512) subS[tid - 384] = subg[tid - 384];
    const LAS float* mylut = lutS + map * LUTS;
    bf16x8 qf[4];
    { const bf16_t* Qp = proj + pcol(1536 + hd * 128 + map * 64) + (rowbase + myq) * PP + 8 * h;
#pragma unroll
      for (int s = 0; s < 4; ++s) qf[s] = *(const bf16x8*)(Qp + 16 * s); }
    const int srow = tid >> 4, sc = tid & 15, soff = srow * KS + sc * 16, svoff = (srow >> 3) * 2048 + (sc >> 2) * 512 + (srow & 7) * 64 + (sc & 3) * 16;
    const unsigned toffK = (unsigned)(srow * PP + sc * 8), toffV = toffK + (unsigned)(pcol(2560 + hd * 128) - pcol(2048 + hd * 128));
    const bf16_t* const Kg = proj + pcol(2048 + hd * 128) + rowbase * PP;
    const int vlane = (4 * h + ((lane & 15) >> 2)) * 64 + ((lane >> 4) & 1) * 32 + (lane & 3) * 8;
    const float c2 = 0.125f * LOG2E;
    f32x16 O[4];
#pragma unroll
    for (int d = 0; d < 4; ++d) O[d] = zero16();
    float mrun = NEGBIG, lrun = 0.f;
    const int NT = min(qb + 1, ntcap);
#define DEXP(x) ((mode == 2) ? (x) : __builtin_amdgcn_exp2f(x))
#define DPV(A_, B_, C_) ((mode == 3) ? (C_) : MFMA32(A_, B_, C_))
    u32x4 kr[4];
#pragma unroll
    for (int j = 0; j < 4; ++j) kr[j] = *(const u32x4*)(Kg + (size_t)(32 * j) * PP + toffK);
#pragma unroll
    for (int j = 0; j < 4; ++j) *(LAS u32x4*)(lds + soff + 32 * j * KS) = kr[j];
#pragma unroll
    for (int j = 0; j < 4; ++j) kr[j] = *(const u32x4*)(Kg + (size_t)(32 * j) * PP + toffV);
#pragma unroll
    for (int j = 0; j < 4; ++j) *(LAS u32x4*)(lds + VOFF + svoff + 8192 * j) = kr[j];
    __syncthreads();
    asm volatile("" : "+v"(qf[0]), "+v"(qf[1]), "+v"(qf[2]), "+v"(qf[3]));
    int buf = 0;
#pragma unroll 1
    for (int t = 0; t < NT; ++t) {
        const size_t go = (size_t)(128 * (t + 1)) * PP;
        if (t + 1 < NT) {
#pragma unroll
            for (int j = 0; j < 4; ++j) kr[j] = *(const u32x4*)(Kg + go + (size_t)(32 * j) * PP + toffK); }
        if (mode == 1) {
            if (t + 1 < NT) {
#pragma unroll
                for (int j = 0; j < 4; ++j) *(LAS u32x4*)(lds + (buf ^ 1) * KBUF + soff + 32 * j * KS) = kr[j];
#pragma unroll
                for (int j = 0; j < 4; ++j) kr[j] = *(const u32x4*)(Kg + go + (size_t)(32 * j) * PP + toffV);
#pragma unroll
                for (int j = 0; j < 4; ++j) *(LAS u32x4*)(lds + VOFF + (buf ^ 1) * VBUF + svoff + 8192 * j) = kr[j]; }
            lrun = 1.0f;
        } else {
            const lp Kb0 = lds + buf * KBUF + map * 128 + r * KS + h * 16, Vb0 = lds + VOFF + buf * VBUF + vlane;
            const int kv0 = 128 * t;
            f32x16 a0, a1, b0, b1;
            bf16x8 w0, w1, w2, w3, x0, x1, x2, x3; float alpha0, alpha1;
#define DIFF_BIAS(P0, P1, KVB, SC, BI) do { \
            if ((KVB) + 63 + 128 <= q0w) { SC = c2; BI = mylut[128];     \
            } else { SC = 1.0f; BI = 0.0f; \
                _Pragma("unroll") for (int i = 0; i < 16; ++i) { \
                    const int d0_ = myq - ((KVB) + crow(i, h)), d1_ = d0_ - 32; \
                    const float l0_ = mylut[min(max(d0_, 0), 128)], l1_ = mylut[min(max(d1_, 0), 128)]; \
                    P0[i] = (d0_ >= 0) ? P0[i] * c2 + l0_ : NEGBIG; P1[i] = (d1_ >= 0) ? P1[i] * c2 + l1_ : NEGBIG; \
                    if ((i & 3) == 3) __builtin_amdgcn_sched_barrier(0); } } } while (0)
            __builtin_amdgcn_s_setprio(1);
            { bf16x8 k0[4];
#pragma unroll
              for (int s = 0; s < 4; ++s) k0[s] = *(const LAS bf16x8*)(Kb0 + s * 32);
              a0 = MFMA32(k0[0], qf[0], zero16());
#pragma unroll
              for (int s = 1; s < 4; ++s) a0 = MFMA32(k0[s], qf[s], a0);
              __builtin_amdgcn_sched_barrier(0);
#pragma unroll
              for (int s = 0; s < 4; ++s) k0[s] = *(const LAS bf16x8*)(Kb0 + 32 * KS + s * 32);
              a1 = MFMA32(k0[0], qf[0], zero16());
#pragma unroll
              for (int s = 1; s < 4; ++s) a1 = MFMA32(k0[s], qf[s], a1); }
            float sca, bia, scb, bib;
            __builtin_amdgcn_s_setprio(0);
            DIFF_BIAS(a0, a1, kv0, sca, bia);
            __builtin_amdgcn_sched_barrier(0);
            bf16x8 vr[4][2];
#define VOFFP(p) ((((p) >> 3) * 16384) + ((((p) & 7) >> 1) * 512) + (((p) & 1) * 8192))
#define VLOAD(p) do { vr[(p) & 3][0] = vfrag<2048>(Vb0 + VOFFP(p)); vr[(p) & 3][1] = vfrag<2048>(Vb0 + VOFFP(p) + 4096); } while (0)
            {
              bf16x8 k0[4];
#pragma unroll
              for (int s = 0; s < 4; ++s) k0[s] = *(const LAS bf16x8*)(Kb0 + 64 * KS + s * 32);
              b0 = MFMA32(k0[0], qf[0], zero16());
#pragma unroll
              for (int s = 1; s < 4; ++s) b0 = MFMA32(k0[s], qf[s], b0);
              float mx = fmaxf(hmax16(a0), hmax16(a1)); mx = fmaxf(mx, __shfl_xor(mx, 32));
              const float cnd0 = mx * sca + bia; const float mnew = (cnd0 > mrun + 8.0f) ? cnd0 : mrun;     alpha0 = __builtin_amdgcn_exp2f(mrun - mnew); const float offa = bia - mnew;
#pragma unroll
              for (int i = 0; i < 16; ++i) a0[i] = DEXP(a0[i] * sca + offa);
              w0 = pack8<0>(a0); w1 = pack8<1>(a0);
              const float s0 = hsum16(a0);
              __builtin_amdgcn_sched_barrier(0);
#pragma unroll
              for (int s = 0; s < 4; ++s) k0[s] = *(const LAS bf16x8*)(Kb0 + 96 * KS + s * 32);
              b1 = MFMA32(k0[0], qf[0], zero16());
#pragma unroll
              for (int s = 1; s < 4; ++s) b1 = MFMA32(k0[s], qf[s], b1);
#pragma unroll
              for (int i = 0; i < 16; ++i) a1[i] = DEXP(a1[i] * sca + offa);
              w2 = pack8<0>(a1); w3 = pack8<1>(a1);
              lrun = lrun * alpha0 + (s0 + hsum16(a1)); mrun = mnew; }
            __builtin_amdgcn_sched_barrier(0);
            VLOAD(0);
            if (__any(alpha0 != 1.0f)) {
#pragma unroll
                for (int d = 0; d < 4; ++d) O[d] = O[d] * alpha0; }
            if (t + 1 < NT) {
#pragma unroll
                for (int j = 0; j < 4; ++j) *(LAS u32x4*)(lds + (buf ^ 1) * KBUF + soff + 32 * j * KS) = kr[j];
#pragma unroll
                for (int j = 0; j < 4; ++j) kr[j] = *(const u32x4*)(Kg + go + (size_t)(32 * j) * PP + toffV); }
            DIFF_BIAS(b0, b1, kv0 + 64, scb, bib);
            __builtin_amdgcn_s_setprio(1);
            __builtin_amdgcn_sched_barrier(0);
            {
                float mx = fmaxf(hmax16(b0), hmax16(b1)); mx = fmaxf(mx, __shfl_xor(mx, 32));
                const float cnd1 = mx * scb + bib; const float mnew1 = (cnd1 > mrun + 8.0f) ? cnd1 : mrun, off1 = bib - mnew1; alpha1 = __builtin_amdgcn_exp2f(mrun - mnew1);
                float sum1 = 0.f; unsigned xw[16];
                __builtin_amdgcn_sched_barrier(0);
#pragma unroll
                for (int j = 0; j < 16; ++j) {
                    if ((j & 1) == 0) VLOAD((j >> 1) + 1);
                    { const int i = j >> 1;
                      if (i & 1) O[i >> 1] = DPV(vr[i & 3][j & 1], (j & 1) ? w3 : w2, O[i >> 1]);
                      else       O[i >> 1] = DPV(vr[i & 3][j & 1], (j & 1) ? w1 : w0, O[i >> 1]); }
                    { float e0, e1;
                      if (j < 8) { e0 = DEXP(b0[2 * j] * scb + off1); e1 = DEXP(b0[2 * j + 1] * scb + off1); }
                      else       { e0 = DEXP(b1[2 * (j - 8)] * scb + off1); e1 = DEXP(b1[2 * (j - 8) + 1] * scb + off1); }
                      sum1 += e0 + e1; xw[j] = cvtpk(e0, e1);
                      asm volatile("" : "+v"(xw[j]), "+v"(sum1)); }
                    __builtin_amdgcn_sched_barrier(0);
                }
                { u32x4 t0 = {xw[0], xw[1], xw[2], xw[3]}, t1 = {xw[4], xw[5], xw[6], xw[7]}, t2 = {xw[8], xw[9], xw[10], xw[11]}, t3 = {xw[12], xw[13], xw[14], xw[15]};
                  x0 = __builtin_bit_cast(bf16x8, t0); x1 = __builtin_bit_cast(bf16x8, t1); x2 = __builtin_bit_cast(bf16x8, t2); x3 = __builtin_bit_cast(bf16x8, t3); }
                lrun = lrun * alpha1 + sum1; mrun = mnew1; }
            if (__any(alpha1 != 1.0f)) {
#pragma unroll
                for (int d = 0; d < 4; ++d) O[d] = O[d] * alpha1; }
            VLOAD(9); VLOAD(10);
#pragma unroll
            for (int i = 0; i < 8; ++i) {
                if (i < 5) VLOAD(8 + i + 3);
                if (i & 1) { O[i >> 1] = DPV(vr[i & 3][0], x2, O[i >> 1]); O[i >> 1] = DPV(vr[i & 3][1], x3, O[i >> 1]); }
                else       { O[i >> 1] = DPV(vr[i & 3][0], x0, O[i >> 1]); O[i >> 1] = DPV(vr[i & 3][1], x1, O[i >> 1]); }
                __builtin_amdgcn_sched_barrier(0);
            }
            __builtin_amdgcn_s_setprio(0);
#undef VLOAD
#undef VOFFP
            if (t + 1 < NT) {
#pragma unroll
                for (int j = 0; j < 4; ++j) *(LAS u32x4*)(lds + VOFF + (buf ^ 1) * VBUF + svoff + 8192 * j) = kr[j]; }
#undef DIFF_BIAS
        }
        __syncthreads();
        buf ^= 1;
    }
#undef DEXP
#undef DPV
    lrun += __shfl_xor(lrun, 32);
    const float inv = 1.0f / lrun;
    LAS float* X = (LAS float*)lds;
    if (map == 1) {
#pragma unroll
        for (int d = 0; d < 4; ++d)
#pragma unroll
            for (int i = 0; i < 16; ++i) X[(wq * 64 + d * 16 + i) * 64 + lane] = O[d][i] * inv;
    }
    __syncthreads();
    if (map == 0) {
        float ssq = 0.f;
#pragma unroll
        for (int d = 0; d < 4; ++d)
#pragma unroll
            for (int i = 0; i < 16; ++i) { const float v = O[d][i] * inv - lam * X[(wq * 64 + d * 16 + i) * 64 + lane]; O[d][i] = v; ssq += v * v; }
        ssq += __shfl_xor(ssq, 32);
        const float rn = __builtin_amdgcn_rsqf(ssq * (1.0f / 128.0f) + 1e-5f) * 0.8f;
        const lp stg = lds + VOFF + (wq * 32 + r) * 272 + 8 * h;
#pragma unroll
        for (int d = 0; d < 4; ++d)
#pragma unroll
            for (int g = 0; g < 4; ++g) {
                const f32x4 gv = *(const LAS f32x4*)(subS + 32 * d + 8 * g + 4 * h);
                u32x2 a; a.x = cvtpk(O[d][4 * g] * rn * gv[0], O[d][4 * g + 1] * rn * gv[1]); a.y = cvtpk(O[d][4 * g + 2] * rn * gv[2], O[d][4 * g + 3] * rn * gv[3]);
                *(LAS u32x2*)(stg + (32 * d + 8 * g) * 2) = a;
            }
    }
    __syncthreads();
    { bf16_t* Ob = obuf + (rowbase + q0) * DM + 512 + hd * 128;
#pragma unroll
      for (int i = 0; i < 4; ++i) { const int p = wid * 64 + lane + 512 * i, row = p >> 4, c = p & 15;
          const u32x4 v = *(const LAS u32x4*)(lds + VOFF + row * 272 + c * 16);
          *(u32x4*)(Ob + (size_t)row * DM + c * 8) = v; } }
    __syncthreads();
}

struct DilState { f32x16 O0, O1; float m, l; bf16x8 qf[4]; };
constexpr int DKS = 144, DCH = 256 * DKS, DVB = 256 * 128, DVOFF = 2 * DCH, DLOFF = DVOFF + 2 * DVB;
constexpr int DL_OWN = 192, DL_OTH = 384;
DI void dil_pv(DilState& st, const f32x16& p, float alpha, const bf16x8 (&vf)[4]) {
    if (__any(alpha != 1.0f)) { st.O0 = st.O0 * alpha; st.O1 = st.O1 * alpha; }
    const bf16x8 w0 = pack8<0>(p), w1 = pack8<1>(p);
    st.O0 = MFMA32(vf[0], w0, st.O0); st.O1 = MFMA32(vf[1], w0, st.O1);
    st.O0 = MFMA32(vf[2], w1, st.O0); st.O1 = MFMA32(vf[3], w1, st.O1);
}
DI f32x16 dil_qk(const DilState& st, lp kb, lp vb, bf16x8 (&vf)[4]) {
    bf16x8 ka[4];
#pragma unroll
    for (int s = 0; s < 4; ++s) ka[s] = *(const LAS bf16x8*)(kb + s * 32);
    vf[0] = vfrag<1024>(vb); vf[1] = vfrag<1024>(vb + 512); vf[2] = vfrag<1024>(vb + 2048); vf[3] = vfrag<1024>(vb + 2048 + 512);
    __builtin_amdgcn_sched_barrier(0);
    f32x16 p = zero16();
#pragma unroll
    for (int s = 0; s < 4; ++s) p = MFMA32(ka[s], st.qf[s], p);
    return p;
}
DI void dil_tile_lut(DilState& st, lp kb, lp vb, const LAS float* lut, const int LSTEP  ) {
    bf16x8 vf[4];
    f32x16 p = dil_qk(st, kb, vb, vf);
    const float c2 = 0.125f * LOG2E;
#pragma unroll
    for (int i = 0; i < 16; ++i) { const int ci = (i & 3) + 8 * (i >> 2); p[i] = p[i] * c2 + lut[(27 - ci) * LSTEP]; }
    float mx = hmax16(p); mx = fmaxf(mx, __shfl_xor(mx, 32));
    const float mnew = (mx > st.m + 8.0f) ? mx : st.m, alpha = __builtin_amdgcn_exp2f(st.m - mnew);
#pragma unroll
    for (int i = 0; i < 16; ++i) p[i] = __builtin_amdgcn_exp2f(p[i] - mnew);
    st.l = st.l * alpha + hsum16(p); st.m = mnew;
    dil_pv(st, p, alpha, vf);
}
DI void dil_tile_far(DilState& st, lp kb, lp vb, float b31, bool edge, int r, int h, const float (&me)[4]) {
    bf16x8 vf[4];
    f32x16 p = dil_qk(st, kb, vb, vf);
    const float c2 = 0.125f * LOG2E;
    const int e = r & 3;
    float v[4];
#pragma unroll
    for (int g = 0; g < 4; ++g) { const float x = (p[4 * g] * me[0] + p[4 * g + 1] * me[1]) + (p[4 * g + 2] * me[2] + p[4 * g + 3] * me[3]); v[g] = x * c2 + b31;
        if (edge && r > e + 8 * g + 4 * h) v[g] = NEGBIG; }
    float mx = fmaxf(fmaxf(v[0], v[1]), fmaxf(v[2], v[3])); mx = fmaxf(mx, __shfl_xor(mx, 32));
    const float mnew = (mx > st.m + 8.0f) ? mx : st.m, alpha = __builtin_amdgcn_exp2f(st.m - mnew);
#pragma unroll
    for (int g = 0; g < 4; ++g) v[g] = __builtin_amdgcn_exp2f(v[g] - mnew);
    st.l = st.l * alpha + ((v[0] + v[1]) + (v[2] + v[3])); st.m = mnew;
#pragma unroll
    for (int g = 0; g < 4; ++g) { p[4 * g] = v[g] * me[0]; p[4 * g + 1] = v[g] * me[1]; p[4 * g + 2] = v[g] * me[2]; p[4 * g + 3] = v[g] * me[3]; }
    dil_pv(st, p, alpha, vf);
}
DI void dil_unit(int b, int head, int span, const bf16_t* proj, bf16_t* obuf, const float* lutg, lp lds) {
    int tid_ = threadIdx.x; asm volatile("" : "+v"(tid_));
    const int tid = tid_, lane = tid & 63, r = lane & 31, h = lane >> 5, wid = __builtin_amdgcn_readfirstlane(tid >> 6);
    const int pr = wid >> 2, c = wid & 3;
    const size_t rowbase = (size_t)b * SEQ; const int T0 = span * 512;
    LAS float* lutOwn = (LAS float*)(lds + DLOFF); LAS float* lutOth = lutOwn + DL_OWN;
    { const float* lg = lutg + head * LUTS;
      for (int i = tid; i < DL_OWN + DL_OTH; i += 512) {
          float val;
          if (i < DL_OWN) { const int d = 4 * (i - 31); const int mult = (d <= 128 ? 1 : 0) + (d <= 512 ? 1 : 0) + ((d & 15) == 0 ? 1 : 0);
              val = (d < 0 || mult == 0) ? NEGBIG : lg[min(d, 128)] + ((mult == 3) ? 1.5849625007211562f : ((mult == 2) ? 1.0f : 0.0f)); }
          else { const int d = (i - DL_OWN) - 127; val = (d >= 0 && d <= 128) ? lg[d] : NEGBIG; }
          lutOwn[i] = val; } }
    float b31 = lutg[head * LUTS + 128];
    float me[4];
#pragma unroll
    for (int e = 0; e < 4; ++e) me[e] = ((r & 3) == e) ? 1.0f : 0.0f;
    DilState st[2];
#pragma unroll
    for (int q = 0; q < 2; ++q) { st[q].O0 = zero16(); st[q].O1 = zero16(); st[q].m = NEGBIG; st[q].l = 0.f;
        const bf16_t* Qp = proj + pcol(head * 64) + (rowbase + T0 + 128 * (2 * pr + q) + c + 4 * r) * PP + 8 * h;
#pragma unroll
        for (int s = 0; s < 4; ++s) st[q].qf[s] = *(const bf16x8*)(Qp + 16 * s); }
    const int x0 = tid >> 3, sc = tid & 7;
    const int rho0 = (x0 & 3) * 32 + (x0 >> 2), soff = rho0 * DKS + sc * 16;
    const int svoff = (rho0 >> 3) * 1024 + (sc >> 2) * 512 + (rho0 & 7) * 64 + (sc & 3) * 16;
    const unsigned toffK = (unsigned)(x0 * PP + sc * 8), toffV = toffK + (unsigned)(4 * (size_t)MTOK * 256);
    const bf16_t* const ubase = proj + pcol(1024 + head * 64) + (rowbase + (size_t)T0) * PP - (size_t)2048 * PP;
    const int vlane = (4 * h + ((lane & 15) >> 2)) * 64 + ((lane >> 4) & 1) * 32 + (lane & 3) * 8;
    const int klane = r * DKS + h * 16;
    const int k0 = (T0 >= 2048) ? 0 : (2048 - T0) / 256, nk = 10 - k0;
    const int kst = max(k0, (10 - (2 * span) % 10) % 10);
#define DIL_K(i) (k0 + (kst - k0 + (i)) % nk)
    u32x4 kr[4];
    { const bf16_t* cb = ubase + (size_t)(256 * kst) * PP;
#pragma unroll
      for (int j = 0; j < 4; ++j) kr[j] = *(const u32x4*)(cb + (size_t)(64 * j) * PP + toffK);
#pragma unroll
      for (int j = 0; j < 4; ++j) { const int o = soff + ((j >> 1) * 128 + 16 * (j & 1)) * DKS; *(LAS u32x4*)(lds + o) = kr[j]; }
#pragma unroll
      for (int j = 0; j < 4; ++j) kr[j] = *(const u32x4*)(cb + (size_t)(64 * j) * PP + toffV);
#pragma unroll
      for (int j = 0; j < 4; ++j) *(LAS u32x4*)(lds + DVOFF + svoff + ((j >> 1) * 16 + 2 * (j & 1)) * 1024) = kr[j]; }
    __syncthreads();
    asm volatile("" : "+v"(b31), "+v"(me[0]), "+v"(me[1]), "+v"(me[2]), "+v"(me[3]));
#pragma unroll
    for (int q = 0; q < 2; ++q) asm volatile("" : "+v"(st[q].qf[0]), "+v"(st[q].qf[1]), "+v"(st[q].qf[2]), "+v"(st[q].qf[3]));
    int buf = 0;
#pragma unroll 1
    for (int ik = 0; ik < nk; ++ik) {
        const int k = DIL_K(ik);
        const bool more = ik + 1 < nk;
        const bf16_t* const cn = ubase + (size_t)(256 * DIL_K(ik + 1)) * PP;
        if (more) {
#pragma unroll
            for (int j = 0; j < 4; ++j) kr[j] = *(const u32x4*)(cn + (size_t)(64 * j) * PP + toffK); }
#pragma unroll 1
        for (int hc = 0; hc < 2; ++hc) {
            const lp Kh = lds + buf * DCH + hc * 128 * DKS + klane, Vh = lds + DVOFF + buf * DVB + hc * 16384 + vlane;
#pragma unroll
            for (int q = 0; q < 2; ++q) {
                const int ch = 2 * k + hc - (2 * pr + q);
                if (ch < 0 || ch > 16) continue;
                if (ch <= 11) { dil_tile_far(st[q], Kh + c * 32 * DKS, Vh + c * 4096, b31, ch == 0, r, h, me); }
                else {
                    const int delta = 2048 - 128 * ch;
                    dil_tile_lut(st[q], Kh + c * 32 * DKS, Vh + c * 4096, lutOwn + (delta / 4 + r + 4 - 4 * h), 1);
                    if (ch >= 15) {
#pragma unroll 1
                        for (int cc = 1; cc < 4; ++cc) { const int cls = (c + cc) & 3;
                            dil_tile_lut(st[q], Kh + cls * 32 * DKS, Vh + cls * 4096, lutOth + (delta + (c - cls) + 4 * r + 19 - 16 * h), 4); }
                    }
                }
            }
            if (more) {
#pragma unroll
                for (int j = 0; j < 4; ++j) {
                    if (hc == 0) *(LAS u32x4*)(lds + (buf ^ 1) * DCH + soff + ((j >> 1) * 128 + 16 * (j & 1)) * DKS) = kr[j];
                    else *(LAS u32x4*)(lds + DVOFF + (buf ^ 1) * DVB + svoff + ((j >> 1) * 16 + 2 * (j & 1)) * 1024) = kr[j]; }
                if (hc == 0) {
#pragma unroll
                    for (int j = 0; j < 4; ++j) kr[j] = *(const u32x4*)(cn + (size_t)(64 * j) * PP + toffV); }
            }
        }
        __syncthreads();
        buf ^= 1;
    }
#undef DIL_K
#pragma unroll
    for (int q = 0; q < 2; ++q) {
        float l = st[q].l; l += __shfl_xor(l, 32);
        const float inv = 1.0f / l;
        const lp stg = lds + (128 * (2 * pr + q) + c + 4 * r) * DKS + 8 * h;
#pragma unroll
        for (int g = 0; g < 4; ++g) {
            u32x2 a; a.x = cvtpk(st[q].O0[4 * g] * inv, st[q].O0[4 * g + 1] * inv); a.y = cvtpk(st[q].O0[4 * g + 2] * inv, st[q].O0[4 * g + 3] * inv); *(LAS u32x2*)(stg + 16 * g) = a;
            u32x2 e; e.x = cvtpk(st[q].O1[4 * g] * inv, st[q].O1[4 * g + 1] * inv); e.y = cvtpk(st[q].O1[4 * g + 2] * inv, st[q].O1[4 * g + 3] * inv); *(LAS u32x2*)(stg + 64 + 16 * g) = e;
        }
    }
    __syncthreads();
    { bf16_t* Ob = obuf + (rowbase + T0) * DM + head * 64;
#pragma unroll
      for (int i = 0; i < 8; ++i) { const int p = wid * 64 + lane + 512 * i, row = p >> 3, cc = p & 7;
          const u32x4 v = *(const LAS u32x4*)(lds + row * DKS + cc * 16);
          *(u32x4*)(Ob + (size_t)row * DM + cc * 8) = v; } }
    __syncthreads();
}
}
#ifndef REP_DIFF
#define REP_DIFF 1
#endif
#ifndef REP_SB
#define REP_SB 1
#endif
#ifndef REP_PRO
#define REP_PRO 1
#endif
#ifndef REP_G
#define REP_G 1
#endif
#ifndef REP_SYNC
#define REP_SYNC 0
#endif
#ifndef REP_DIL
#define REP_DIL 1
#endif
#ifndef PHMASK
#define PHMASK 255
#endif
constexpr size_t MiB = (size_t)1 << 20;
constexpr size_t WS_SS = 0;
constexpr size_t WS_LUT = 2 * MiB, WS_BAR = 3 * MiB;
constexpr size_t WS_WINE = 4 * MiB, WS_WOUTE = 10 * MiB, WS_WINO = 12 * MiB, WS_WOUTO = 18 * MiB, WS_WUP = 20 * MiB, WS_WDN = 36 * MiB, WS_WG = 52 * MiB, WS_WPP = 56 * MiB;
constexpr size_t WS_HBA = 64 * MiB, WS_HBB = 192 * MiB;
constexpr size_t WS_PB = 320 * MiB;
constexpr size_t WS_BIG = 384 * MiB;
constexpr size_t WS_END = 896 * MiB;
constexpr int LDS_BYTES = 163840;
typedef unsigned short bf16;
typedef unsigned v4u __attribute__((ext_vector_type(4)));
typedef float f32x4 __attribute__((ext_vector_type(4)));

__device__ __forceinline__ unsigned f2bf(float f) { unsigned u = __builtin_bit_cast(unsigned, f); return (u + 0x7fffu + ((u >> 16) & 1u)) >> 16; }
__device__ __forceinline__ unsigned pk2(float lo, float hi) { return f2bf(lo) | (f2bf(hi) << 16); }
__device__ __forceinline__ float wave_sum(float v) {
#pragma unroll
    for (int o = 1; o < 64; o <<= 1) v += __shfl_xor(v, o);
    return v;
}
__device__ __forceinline__ void transpose_item(const float* W, int K, int N, bf16* WT, const float* g, LAS float* scr, int item, int lane) {
    const int nblk = N / 32, kb = item / nblk, nb = item % nblk, k0 = 64 * kb, n0 = 32 * nb;
#pragma unroll 8
    for (int i = 0; i < 32; ++i) { const int kk = 2 * i + (lane >> 5); scr[kk * 33 + (lane & 31)] = W[(size_t)(k0 + kk) * N + n0 + (lane & 31)]; }
    asm volatile("s_waitcnt lgkmcnt(0)" ::: "memory");
    const int c = lane & 7;
    float gs[8];
#pragma unroll
    for (int e = 0; e < 8; ++e) gs[e] = g ? g[k0 + 8 * c + e] : 1.0f;
#pragma unroll
    for (int j = 0; j < 4; ++j) { const int n = (lane >> 3) + 8 * j; const LAS float* s = scr + (8 * c) * 33 + n;
        v4u o; o.x = pk2(s[0 * 33] * gs[0], s[1 * 33] * gs[1]); o.y = pk2(s[2 * 33] * gs[2], s[3 * 33] * gs[3]); o.z = pk2(s[4 * 33] * gs[4], s[5 * 33] * gs[5]); o.w = pk2(s[6 * 33] * gs[6], s[7 * 33] * gs[7]);
        *(v4u*)(WT + (size_t)(n0 + n) * K + k0 + 8 * c) = o; }
    asm volatile("s_waitcnt lgkmcnt(0)" ::: "memory");
}
__device__ __forceinline__ int t5_bucket(int n) {
    if (n < 16) return n;
    const float v = logf((float)n / 16.0f) / 2.0794415416798357f * 16.0f;
    int l = 16 + (int)v; return l < 31 ? l : 31;
}

#define XB_TMO      128
#define XB_XCNT(j)  (256  + 64 * (j))
#define XB_XSUB(j)  (1280 + 64 * (j))
#define XB_XGEN(j)  (2304 + 64 * (j))
#define XB_TOP      3328
#define XB_TOPGEN   3392
#define XCD_BAR_WORDS 3456
#define XB_SPIN_CAP (1u << 18)

__device__ __forceinline__ unsigned xb_ld(unsigned* p)              { return __hip_atomic_load(p, __ATOMIC_RELAXED, __HIP_MEMORY_SCOPE_AGENT); }
__device__ __forceinline__ unsigned xb_add(unsigned* p, unsigned v) { return __hip_atomic_fetch_add(p, v, __ATOMIC_RELAXED, __HIP_MEMORY_SCOPE_AGENT); }
__device__ __forceinline__ unsigned xb_xcc_id() { return (unsigned)__builtin_amdgcn_s_getreg((3 << 11) | 20) & 0xFu; }
#define XB_SPIN(cond, bar) do { unsigned _sp = 0; while (cond) { __builtin_amdgcn_s_sleep(1); \
    if ((++_sp & 255u) == 0u) { if (xb_ld(&(bar)[XB_TMO])) break; if (_sp > XB_SPIN_CAP) { atomicAdd(&(bar)[XB_TMO], 1u); break; } } } } while (0)

struct XcdBarrier {
    unsigned* bar; unsigned x;
    volatile LAS unsigned* st;
};

__device__ __forceinline__ XcdBarrier xcd_barrier_post(unsigned* bar, volatile LAS unsigned* st) {
    XcdBarrier b; b.bar = bar; b.x = xb_xcc_id(); b.st = st;
    if (threadIdx.x == 0) (void)xb_add(&bar[XB_XCNT(b.x)], 1u);
    return b;
}
__device__ __forceinline__ void xcd_barrier_complete(unsigned* bar, unsigned x, unsigned& nloc, unsigned& nx) {
    const unsigned G = gridDim.x * gridDim.y * gridDim.z;
    unsigned sum, cnt, mine, sp = 0u;
    for (;;) {
        sum = 0u; cnt = 0u; mine = 0u;
#pragma unroll
        for (unsigned j = 0; j < 16; ++j) { const unsigned c = xb_ld(&bar[XB_XCNT(j)]); sum += c; cnt += (c > 0u) ? 1u : 0u; mine = (j == x) ? c : mine; }
        if (sum == G) break;
        __builtin_amdgcn_s_sleep(1);
        if ((++sp & 255u) == 0u) { if (xb_ld(&bar[XB_TMO])) break; if (sp > XB_SPIN_CAP) { atomicAdd(&bar[XB_TMO], 1u); break; } }
    }
    nloc = mine > 0u ? mine : 1u; nx = cnt > 0u ? cnt : 1u;
}

__device__ __forceinline__ void xcd_barrier(const XcdBarrier& b) {
    asm volatile("s_waitcnt vmcnt(0)" ::: "memory");
    __syncthreads();
    if (threadIdx.x == 0) {
        unsigned* bar = b.bar;
        __builtin_amdgcn_s_waitcnt(0);
        unsigned nloc = b.st[0], nx = b.st[1];
        if (nloc == 0u) { xcd_barrier_complete(bar, b.x, nloc, nx); b.st[0] = nloc; b.st[1] = nx; }
        const unsigned old = xb_add(&bar[XB_XSUB(b.x)], 1u);
        const unsigned gen = old / nloc;
        if (old + 1u == (gen + 1u) * nloc) {
            __builtin_amdgcn_fence(__ATOMIC_RELEASE, "agent");
            asm volatile("s_waitcnt vmcnt(0)" ::: "memory");
            const unsigned og = xb_add(&bar[XB_TOP], 1u);
            const unsigned tg = og / nx;
            if (og + 1u == (tg + 1u) * nx) xb_add(&bar[XB_TOPGEN], 1u);
            else XB_SPIN(xb_ld(&bar[XB_TOPGEN]) == tg, bar);
            __builtin_amdgcn_fence(__ATOMIC_ACQUIRE, "agent");
            xb_add(&bar[XB_XGEN(b.x)], 1u);
            asm volatile("s_waitcnt vmcnt(0)" ::: "memory");
        } else {
            XB_SPIN(xb_ld(&bar[XB_XGEN(b.x)]) == gen, bar);
            __builtin_amdgcn_fence(__ATOMIC_ACQUIRE, "agent");
            asm volatile("s_waitcnt vmcnt(0)" ::: "memory");
        }
    }
    __syncthreads();
}

struct Args { const float* in[20]; float* out; unsigned char* ws; };
enum { I_X = 0, I_P, I_T5, I_WINE, I_WOUTE, I_LQ1, I_LK1, I_LQ2, I_LK2, I_SUBG, I_WINO, I_WOUTO, I_GMIX, I_GMLP, I_WUP, I_WDN, I_GPLE, I_WG, I_WPP, I_GFIN };

__global__ void __launch_bounds__(512, 2) trunk_fwd(Args a) {
    extern __shared__ __attribute__((aligned(16))) unsigned char lds_raw[];
    cg::grid_group grid = cg::this_grid();
    LAS unsigned char* lds = (LAS unsigned char*)lds_raw;
    int tidp = threadIdx.x; asm volatile("" : "+v"(tidp));
    const int tid = tidp;
    const int G = gridDim.x, bx = blockIdx.x;
    const int vcu = (G % 8 == 0) ? (bx % 8) * (G / 8) + bx / 8 : bx;
    unsigned char* ws = a.ws;
    volatile LAS unsigned* bst = (volatile LAS unsigned*)(lds + LDS_BYTES - 64);
    if (tid < 2) bst[tid] = 0u;
#define WSP ({ unsigned char* w_ = a.ws; asm volatile("" : "+s"(w_)); w_; })
#define ssb ((float*)(WSP + WS_SS))
#define lutg ((float*)(WSP + WS_LUT))
#define hbA ((bf16*)(WSP + WS_HBA))
#define hbB ((bf16*)(WSP + WS_HBB))
#define pb ((bf16*)(WSP + WS_PB))
#define proj ((bf16*)(WSP + WS_BIG))
#define obuf ((bf16*)(WSP + WS_BIG + 384 * MiB))
#define ubuf ((bf16*)(WSP + WS_BIG))
#define ppb ((bf16*)(WSP + WS_BIG))
    unsigned* barw = (unsigned*)(WSP + WS_BAR);
    float* out = a.out;

    for (int rep = 0; rep < REP_PRO; ++rep) {
        const int lane = tid & 63, wave = __builtin_amdgcn_readfirstlane(tid >> 6);
        LAS float* scr = (LAS float*)(lds + wave * 16384);
        const int gw = vcu * 8 + wave, NGW = G * 8;
#define TR_ITEMS(K, N) (((K) / 64) * ((N) / 32))
        for (int it = gw; it < 13568; it += NGW) {
            int rr = it;
            if (rr < TR_ITEMS(1024, 3072)) { transpose_item(a.in[I_WINE], 1024, 3072, (bf16*)(WSP + WS_WINE), a.in[I_GMIX], scr, rr, lane); continue; } rr -= TR_ITEMS(1024, 3072);
            if (rr < TR_ITEMS(1024, 1024)) { transpose_item(a.in[I_WOUTE], 1024, 1024, (bf16*)(WSP + WS_WOUTE), nullptr, scr, rr, lane); continue; } rr -= TR_ITEMS(1024, 1024);
            if (rr < TR_ITEMS(1024, 3072)) { transpose_item(a.in[I_WINO], 1024, 3072, (bf16*)(WSP + WS_WINO), a.in[I_GMIX] + 1024, scr, rr, lane); continue; } rr -= TR_ITEMS(1024, 3072);
            if (rr < TR_ITEMS(1024, 1024)) { transpose_item(a.in[I_WOUTO], 1024, 1024, (bf16*)(WSP + WS_WOUTO), nullptr, scr, rr, lane); continue; } rr -= TR_ITEMS(1024, 1024);
            if (rr < 2 * TR_ITEMS(1024, 4096)) { const int L = rr / TR_ITEMS(1024, 4096); rr -= L * TR_ITEMS(1024, 4096);
                transpose_item(a.in[I_WUP] + (size_t)L * 1024 * 4096, 1024, 4096, (bf16*)(WSP + WS_WUP) + (size_t)L * 1024 * 4096, a.in[I_GMLP] + L * 1024, scr, rr, lane); continue; } rr -= 2 * TR_ITEMS(1024, 4096);
            if (rr < 2 * TR_ITEMS(4096, 1024)) { const int L = rr / TR_ITEMS(4096, 1024); rr -= L * TR_ITEMS(4096, 1024);
                transpose_item(a.in[I_WDN] + (size_t)L * 1024 * 4096, 4096, 1024, (bf16*)(WSP + WS_WDN) + (size_t)L * 1024 * 4096, nullptr, scr, rr, lane); continue; } rr -= 2 * TR_ITEMS(4096, 1024);
            if (rr < 2 * TR_ITEMS(1024, 1024)) { const int L = rr / TR_ITEMS(1024, 1024); rr -= L * TR_ITEMS(1024, 1024);
                transpose_item(a.in[I_WG] + (size_t)L * 1024 * 1024, 1024, 1024, (bf16*)(WSP + WS_WG) + (size_t)L * 1024 * 1024, a.in[I_GPLE] + L * 1024, scr, rr, lane); continue; } rr -= 2 * TR_ITEMS(1024, 1024);
            { const int L = rr / TR_ITEMS(256, 1024); rr -= L * TR_ITEMS(256, 1024);
                transpose_item(a.in[I_WPP] + (size_t)L * 256 * 1024, 256, 1024, (bf16*)(WSP + WS_WPP) + (size_t)L * 256 * 1024, nullptr, scr, rr, lane); }
        }
        const float* x = a.in[I_X];
        for (int m = gw; m < MTOK; m += 4 * NGW) {
            f32x4 v[4][4]; float s[4];
#pragma unroll
            for (int q = 0; q < 4; ++q) { const int mm = m + q * NGW; if (mm < MTOK) { const f32x4* xr = (const f32x4*)(x + (size_t)mm * DM) + lane;
#pragma unroll
                for (int j = 0; j < 4; ++j) v[q][j] = xr[64 * j]; } }
#pragma unroll
            for (int q = 0; q < 4; ++q) { const int mm = m + q * NGW; if (mm < MTOK) { float t = 0.f;
#pragma unroll
                for (int j = 0; j < 4; ++j) t += (v[q][j].x * v[q][j].x + v[q][j].y * v[q][j].y) + (v[q][j].z * v[q][j].z + v[q][j].w * v[q][j].w);
                s[q] = wave_sum(t);
                unsigned long long* o8 = (unsigned long long*)(hbB + (size_t)mm * DM) + lane;
#pragma unroll
                for (int j = 0; j < 4; ++j) o8[64 * j] = (unsigned long long)pk2(v[q][j].x, v[q][j].y) | ((unsigned long long)pk2(v[q][j].z, v[q][j].w) << 32);
                if (lane == 0) ssb[mm] = s[q]; } }
        }
        { const f32x4* p4 = (const f32x4*)a.in[I_P]; unsigned long long* o8 = (unsigned long long*)pb;
          const size_t n4 = (size_t)2 * MTOK * PLED / 4, stride = (size_t)G * 512;
          for (size_t i = (size_t)bx * 512 + tid; i < n4; i += 4 * stride) { f32x4 v[4];
#pragma unroll
              for (int q = 0; q < 4; ++q) if (i + q * stride < n4) v[q] = p4[i + q * stride];
#pragma unroll
              for (int q = 0; q < 4; ++q) if (i + q * stride < n4) o8[i + q * stride] = (unsigned long long)pk2(v[q].x, v[q].y) | ((unsigned long long)pk2(v[q].z, v[q].w) << 32); } }
        { const size_t n = (size_t)6 * MTOK, stride = (size_t)G * 512; float* z = ssb + MTOK;
          for (size_t i = (size_t)bx * 512 + tid; i < n; i += stride) z[i] = 0.f; }
        if (bx == 0) for (int i = tid; i < XCD_BAR_WORDS; i += 512) barw[i] = 0u;
        if (bx == 0) { const float* tab = a.in[I_T5];
            for (int i = tid; i < 16 * 129; i += 512) { const int slot = i / 129, d = i % 129; lutg[slot * LUTS + d] = tab[t5_bucket(d) * 16 + slot] * LOG2E; } }
    }
    grid.sync();
    const XcdBarrier xbar = xcd_barrier_post(barw, bst);
#pragma unroll 1
    for (int i = 0; i < REP_SYNC; ++i) xcd_barrier(xbar);

    float lam;
    { float s1 = 0.f, s2 = 0.f;
      for (int i = 0; i < 64; ++i) { s1 += a.in[I_LQ1][i] * a.in[I_LK1][i]; s2 += a.in[I_LQ2][i] * a.in[I_LK2][i]; }
      lam = expf(s1) - expf(s2) + 0.2f; lam = __uint_as_float(__builtin_amdgcn_readfirstlane(__float_as_uint(lam))); }

#pragma unroll 1
    for (int L = 0; L < 2; ++L) {
        float* ss_in0 = ssb + (size_t)(3 * L) * MTOK;
        float* ss_a = ssb + (size_t)(3 * L + 1) * MTOK;
        float* ss_b = ssb + (size_t)(3 * L + 2) * MTOK;
        float* ss_c = ssb + (size_t)(3 * L + 3) * MTOK;
#if PHMASK & 1
#pragma unroll 1
        for (int rep = 0; rep < REP_G; ++rep)
        { pg8::Gemm g{hbB, (const bf16*)(WSP + (L == 0 ? WS_WINE : WS_WINO)), MTOK, NPROJ, DM}; pg8::StaticOrder S; S.init(MTOK, NPROJ, G, bx);
          pg8::EpiNormBf16<0, true> E{proj, MTOK, ss_in0};
          pg8::gemm_phase<pg8::EpiNormBf16<0, true>, pg8::StaticOrder, true, true>(lds, g, S, E); }
#endif
        xcd_barrier(xbar);
#if PHMASK & 2
        if (L == 0) {
#ifdef PROBE_UNIT_OVERHEAD
#ifndef PROBE_MODE
#define PROBE_MODE 0
#endif
            if (G == 256) { const int bh = vcu >> 3, sidx = vcu & 7;
#pragma unroll 1
                for (int i = 0; i < 8; ++i) { const int qb = 8 * i + ((sidx + i) & 7); att::diff_unit(bh >> 2, bh & 3, qb, proj, obuf, lutg, lam, a.in[I_SUBG], lds, PROBE_UNIT_OVERHEAD, PROBE_MODE); } }
#endif
            for (int rep = 0; rep < REP_DIFF; ++rep)
            if (G == 256) {
                const int bh = vcu >> 3, sidx = vcu & 7;
#pragma unroll 1
                for (int i = 0; i < 8; ++i) { const int qb = 8 * i + ((sidx + i) & 7);
                    att::diff_unit(bh >> 2, bh & 3, qb, proj, obuf, lutg, lam, a.in[I_SUBG], lds); }
            } else {
#pragma unroll 1
                for (int u = vcu; u < 2048; u += G) { const int bh = u & 31, qb = 63 - (u >> 5); att::diff_unit(bh >> 2, bh & 3, qb, proj, obuf, lutg, lam, a.in[I_SUBG], lds); }
            }
            for (int rep = 0; rep < REP_SB; ++rep)
#pragma unroll 1
            for (int u = vcu; u < 2048; u += G) { const int bh = u & 63, qb = u >> 6; att::sb_unit(bh >> 3, bh & 7, qb, proj, obuf, lds); }
        }
#endif
#if PHMASK & 4
        if (L == 1) {
            for (int rep = 0; rep < REP_DIL; ++rep)
#pragma unroll 1
            for (int i = 0; i * G + vcu < 2048; ++i) {
                int b, head, span;
                if (G == 256) { const int j = vcu & 31, combo = i * 16 + 2 * (vcu >> 5) + (j >> 4); b = combo >> 4; head = combo & 15; span = ((j & 15) + 4 * (i >> 1)) & 15; if ((i & 1) && span < 4) span = 3 - span; }
                else { const int u = i * G + vcu; span = u & 15; head = (u >> 4) & 15; b = u >> 8; }
                att::dil_unit(b, head, span, proj, obuf, lutg, lds);
            }
        }
#endif
        xcd_barrier(xbar);
#if PHMASK & 8
        { pg8::Gemm g{obuf, (const bf16*)(WSP + (L == 0 ? WS_WOUTE : WS_WOUTO)), MTOK, DM, DM}; pg8::StaticOrder S; S.init(MTOK, DM, G, bx);
          pg8::EpiResid<false> E{nullptr, hbB, hbA, ss_a};
          pg8::gemm_phase<pg8::EpiResid<false>, pg8::StaticOrder, true, true>(lds, g, S, E); }
#endif
        xcd_barrier(xbar);
#if PHMASK & 16
#pragma unroll 1
        for (int rep = 0; rep < REP_G; ++rep)
        { pg8::Gemm g{hbA, (const bf16*)(WSP + WS_WUP) + (size_t)L * DM * DFF, MTOK, DFF, DM}; pg8::StaticOrder S; S.init(MTOK, DFF, G, bx);
          pg8::EpiNormBf16<1> E{ubuf, DFF, ss_a};
          pg8::gemm_phase<pg8::EpiNormBf16<1>, pg8::StaticOrder, true, true>(lds, g, S, E); }
#endif
        xcd_barrier(xbar);
#if PHMASK & 32
        { pg8::Gemm g{ubuf, (const bf16*)(WSP + WS_WDN) + (size_t)L * DM * DFF, MTOK, DM, DFF}; pg8::StaticOrder S; S.init(MTOK, DM, G, bx);
          pg8::EpiResid<false> E{nullptr, hbA, hbA, ss_b};
          pg8::gemm_phase<pg8::EpiResid<false>, pg8::StaticOrder, true, true>(lds, g, S, E); }
#endif
        xcd_barrier(xbar);
#if PHMASK & 64
        { int kpp = PLED; asm volatile("" : "+s"(kpp)); pg8::Gemm g{pb + (size_t)L * MTOK * PLED, (const bf16*)(WSP + WS_WPP) + (size_t)L * PLED * DM, MTOK, DM, kpp}; pg8::StaticOrder S; S.init(MTOK, DM, G, bx);
          pg8::EpiNormBf16<0> E{ppb, DM, nullptr};
          pg8::gemm_phase<pg8::EpiNormBf16<0>, pg8::StaticOrder, true, true>(lds, g, S, E); }
#endif
#if PHMASK & 128
        { pg8::Gemm g{hbA, (const bf16*)(WSP + WS_WG) + (size_t)L * DM * DM, MTOK, DM, DM}; pg8::StaticOrder S; S.init(MTOK, DM, G, bx);
          pg8::EpiGate E{hbA, hbB, ss_c, ss_b, ppb};
          pg8::gemm_phase<pg8::EpiGate, pg8::StaticOrder, true, true>(lds, g, S, E); }
#endif
        xcd_barrier(xbar);
    }
    { int tidf = threadIdx.x; asm volatile("" : "+v"(tidf)); const int lane = tidf & 63, wave = __builtin_amdgcn_readfirstlane(tidf >> 6);
      const int gw = bx * 8 + wave, NGW = G * 8; const float* ss = ssb + (size_t)6 * MTOK; const f32x4* g4 = (const f32x4*)a.in[I_GFIN] + 2 * lane;
      f32x4 gv[4];
#pragma unroll
      for (int j = 0; j < 2; ++j) { gv[2 * j] = g4[128 * j]; gv[2 * j + 1] = g4[128 * j + 1]; }
      for (int m = gw; m < MTOK; m += 4 * NGW) {
          v4u w[4][2]; float rs[4];
#pragma unroll
          for (int q = 0; q < 4; ++q) { const int mm = m + q * NGW; if (mm < MTOK) { const v4u* hi = (const v4u*)(hbB + (size_t)mm * DM) + lane; w[q][0] = hi[0]; w[q][1] = hi[64]; rs[q] = ss[mm]; } }
#pragma unroll
          for (int q = 0; q < 4; ++q) { const int mm = m + q * NGW; if (mm < MTOK) { const float r = __builtin_amdgcn_rsqf(rs[q] * (1.0f / 1024.0f) + 1e-6f);
              f32x4* o = (f32x4*)(out + (size_t)mm * DM) + 2 * lane;
#pragma unroll
              for (int j = 0; j < 2; ++j) { f32x4 p0, p1; pg8::unpack8(w[q][j], p0, p1); o[128 * j] = p0 * r * gv[2 * j]; o[128 * j + 1] = p1 * r * gv[2 * j + 1]; } } }
      } }
}

#undef ssb
#undef lutg
#undef hbA
#undef hbB
#undef pb
#undef proj
#undef obuf
#undef ubuf
#undef ppb
extern "C" void kernel_launch(void* const* d_in, const int* in_sizes, int n_in, void* d_out, int out_size, void* d_ws, size_t ws_size, hipStream_t stream) {
    static int grid_blocks = 0;
    if (grid_blocks == 0) {
        if (n_in != 20 || in_sizes[0] != MTOK * DM || out_size != MTOK * DM || ws_size < WS_END) {
            fprintf(stderr, "kernel_launch: unexpected shapes (n_in %d, in0 %d, out %d, ws %zu); nothing launched\n", n_in, n_in > 0 ? in_sizes[0] : -1, out_size, ws_size); grid_blocks = -1; return; }
        int dev = 0, cus = 0, per_cu = 0;
        (void)hipGetDevice(&dev); (void)hipDeviceGetAttribute(&cus, hipDeviceAttributeMultiprocessorCount, dev);
        if (hipFuncSetAttribute((const void*)trunk_fwd, hipFuncAttributeMaxDynamicSharedMemorySize, LDS_BYTES) != hipSuccess) { fprintf(stderr, "kernel_launch: hipFuncSetAttribute failed\n"); grid_blocks = -1; return; }
        if (hipOccupancyMaxActiveBlocksPerMultiprocessor(&per_cu, (const void*)trunk_fwd, 512, LDS_BYTES) != hipSuccess || per_cu < 1) { fprintf(stderr, "kernel_launch: occupancy query says %d blocks per CU\n", per_cu); per_cu = 1; }
        (void)hipGetLastError();
        grid_blocks = cus * per_cu;
    }
    if (grid_blocks < 0) return;
    Args a{};
    for (int i = 0; i < 20; ++i) a.in[i] = (const float*)d_in[i];
    a.out = (float*)d_out; a.ws = (unsigned char*)d_ws;
    void* args[] = {&a};
    hipError_t e = hipLaunchCooperativeKernel((const void*)trunk_fwd, dim3(grid_blocks), dim3(512), args, LDS_BYTES, stream);
    if (e != hipSuccess) fprintf(stderr, "cooperative launch failed: %s (grid %d)\n", hipGetErrorString(e), grid_blocks);
}
```

```cpp
#include <hip/hip_runtime.h>
#include <hip/hip_cooperative_groups.h>
#include <cstdio>
#include <cstdint>
namespace cg = cooperative_groups;
namespace pg8 {
#define PG8_LAS __attribute__((address_space(3)))
typedef unsigned short bf16_t;
typedef short bf16x8 __attribute__((ext_vector_type(8)));
typedef float f32x4 __attribute__((ext_vector_type(4)));
typedef unsigned u32x4 __attribute__((ext_vector_type(4)));
constexpr int BM = 256, BK = 64, HALF = 128, HTB = HALF * BK * 2  , STAGE_BYTES = 8 * HTB, NXCD = 8, WGM = 8;

__host__ __device__ __forceinline__ int lds_byte(int r, int c) { const int st = (r >> 4) * 2 + (c >> 5), rr = r & 15, cc = c & 31, ob = rr * 64 + cc * 2; return st * 1024 + (ob ^ (((ob >> 9) & 1) << 5)); }
__host__ __device__ __forceinline__ void stage_rc(int b, int& R, int& C) { const int st = b / 1024, sb = b % 1024, swz = sb ^ (((sb >> 9) & 1) << 5); R = (st >> 1) * 16 + swz / 64; C = (st & 1) * 32 + (swz % 64) / 2; }
__host__ __device__ __forceinline__ int perm32(int rho) { const int n = rho >> 4, i = rho & 15; return 8 * (i >> 2) + 4 * n + (i & 3); }

struct Unit { int pm, pn; };
struct Gemm { const bf16_t* A; const bf16_t* Bt; int M, N, K; };

struct StaticOrder {
    int nM, nN, nwg, G, c;
    __host__ __device__ void init(int M, int N, int G_, int c_) { nM = M / BM; nN = N / BM; nwg = nM * nN; G = G_; c = c_; }
    __host__ __device__ bool next(int i, Unit& u) const {
        const long L = (long)i * G + c; if (L >= nwg) return false;
        int wgid = (int)L; { const int q = nwg / NXCD, r = nwg % NXCD, xcd = wgid % NXCD, off = wgid / NXCD; wgid = (xcd < r ? xcd * (q + 1) : r * (q + 1) + (xcd - r) * q) + off; }
        const int nig = WGM * nN, gid = wgid / nig, fm = gid * WGM, gsz = (nM - fm) < WGM ? (nM - fm) : WGM;
        u.pm = fm + ((wgid % nig) % gsz); u.pn = (wgid % nig) / gsz; return true;
    }
    __device__ __forceinline__ void a_ready(const Unit&) const {}
    __device__ __forceinline__ void done(const Unit&) const {}
};

__device__ __forceinline__ unsigned cvt_pk_bf16(float lo, float hi) { unsigned r; asm volatile("v_cvt_pk_bf16_f32 %0, %1, %2" : "=v"(r) : "v"(lo), "v"(hi)); return r; }
__device__ __forceinline__ float row_rstd(const float* ss, int row) { return __builtin_amdgcn_rsqf(ss[row] * (1.0f / 1024.0f) + 1e-6f); }
template <int ACT  , bool TILED = false  > struct EpiNormBf16 {
    static constexpr bool PERM = true, AFTER_DRAIN = false;
    bf16_t* O; int ldc; const float* ss;
    __device__ __forceinline__ void operator()(const f32x4 (&acc)[2][2][4][2], const Unit& u, int wr, int wc, int fr, int fq) const {
        const int row0 = u.pm * BM + wr * 64 + fr, col0 = u.pn * BM + wc * 32 + 8 * fq;
        float rsv[8];
#pragma unroll
        for (int i = 0; i < 8; ++i) rsv[i] = ss ? ss[row0 + (i >> 2) * HALF + (i & 3) * 16] : 1.0f;
#pragma unroll
        for (int i = 0; i < 8; ++i) rsv[i] = ss ? __builtin_amdgcn_rsqf(rsv[i] * (1.0f / 1024.0f) + 1e-6f) : 1.0f;
#pragma unroll
        for (int ai = 0; ai < 2; ++ai)
#pragma unroll
            for (int m = 0; m < 4; ++m) {
                const int row = row0 + ai * HALF + m * 16;
                const float rs = rsv[ai * 4 + m];
                bf16_t* rowp = TILED ? O + (size_t)u.pn * ((size_t)ldc * BM) + (size_t)row * BM + (col0 - u.pn * BM) : O + (size_t)row * ldc + col0;
#pragma unroll
                for (int bj = 0; bj < 2; ++bj) {
                    f32x4 v0 = acc[ai][bj][m][0] * rs, v1 = acc[ai][bj][m][1] * rs;
                    if (ACT == 1) {
#pragma unroll
                        for (int e = 0; e < 4; ++e) { const float a = fmaxf(v0[e], 0.f), b = fmaxf(v1[e], 0.f); v0[e] = a * a; v1[e] = b * b; }
                    }
                    u32x4 w; w.x = cvt_pk_bf16(v0[0], v0[1]); w.y = cvt_pk_bf16(v0[2], v0[3]); w.z = cvt_pk_bf16(v1[0], v1[1]); w.w = cvt_pk_bf16(v1[2], v1[3]);
                    *(u32x4*)(rowp + bj * HALF) = w;
                }
            }
    }
};
__device__ __forceinline__ void unpack8(const u32x4 pw, f32x4& p0, f32x4& p1) {
    p0[0] = __uint_as_float(pw.x << 16); p0[1] = __uint_as_float(pw.x & 0xffff0000u); p0[2] = __uint_as_float(pw.y << 16); p0[3] = __uint_as_float(pw.y & 0xffff0000u);
    p1[0] = __uint_as_float(pw.z << 16); p1[1] = __uint_as_float(pw.z & 0xffff0000u); p1[2] = __uint_as_float(pw.w << 16); p1[3] = __uint_as_float(pw.w & 0xffff0000u);
}
template <bool BASE_F32> struct EpiResid {
    static constexpr bool PERM = true, AFTER_DRAIN = false;
    const float* basef; const bf16_t* baseb; bf16_t* hb; float* ss_out;
    __device__ __forceinline__ void operator()(const f32x4 (&acc)[2][2][4][2], const Unit& u, int wr, int wc, int fr, int fq) const {
        const int row0 = u.pm * BM + wr * 64 + fr, col0 = u.pn * BM + wc * 32 + 8 * fq;
#pragma unroll
        for (int ai = 0; ai < 2; ++ai) {
            f32x4 bv[4][2][2];
#pragma unroll
            for (int m = 0; m < 4; ++m)
#pragma unroll
                for (int bj = 0; bj < 2; ++bj) {
                    const size_t off = (size_t)(row0 + ai * HALF + m * 16) * 1024 + col0 + bj * HALF;
                    if (BASE_F32) { bv[m][bj][0] = *(const f32x4*)(basef + off); bv[m][bj][1] = *(const f32x4*)(basef + off + 4); }
                    else { const u32x4 w = *(const u32x4*)(baseb + off); bv[m][bj][0] = __builtin_bit_cast(f32x4, w); }
                }
#pragma unroll
            for (int m = 0; m < 4; ++m) {
                const int row = row0 + ai * HALF + m * 16; float sq = 0.f;
#pragma unroll
                for (int bj = 0; bj < 2; ++bj) {
                    const size_t off = (size_t)row * 1024 + col0 + bj * HALF;
                    f32x4 b0, b1;
                    if (BASE_F32) { b0 = bv[m][bj][0]; b1 = bv[m][bj][1]; } else unpack8(__builtin_bit_cast(u32x4, bv[m][bj][0]), b0, b1);
                    const f32x4 v0 = acc[ai][bj][m][0] + b0, v1 = acc[ai][bj][m][1] + b1;
                    u32x4 w; w.x = cvt_pk_bf16(v0[0], v0[1]); w.y = cvt_pk_bf16(v0[2], v0[3]); w.z = cvt_pk_bf16(v1[0], v1[1]); w.w = cvt_pk_bf16(v1[2], v1[3]);
                    *(u32x4*)(hb + off) = w;
                    sq += (v0[0] * v0[0] + v0[1] * v0[1]) + (v0[2] * v0[2] + v0[3] * v0[3]) + (v1[0] * v1[0] + v1[1] * v1[1]) + (v1[2] * v1[2] + v1[3] * v1[3]);
                }
                sq += __shfl_xor(sq, 16); sq += __shfl_xor(sq, 32);
                if (fq == 0) unsafeAtomicAdd(ss_out + row, sq);
            }
        }
    }
};
struct EpiGate {
    static constexpr bool PERM = true, AFTER_DRAIN = false;
    const bf16_t* baseb; bf16_t* hb; float* ss_out; const float* ss_in; const bf16_t* pp;
    __device__ __forceinline__ void operator()(const f32x4 (&acc)[2][2][4][2], const Unit& u, int wr, int wc, int fr, int fq) const {
        const int row0 = u.pm * BM + wr * 64 + fr, col0 = u.pn * BM + wc * 32 + 8 * fq;
        float rsv[8];
#pragma unroll
        for (int i = 0; i < 8; ++i) rsv[i] = ss_in[row0 + (i >> 2) * HALF + (i & 3) * 16];
#pragma unroll
        for (int ai = 0; ai < 2; ++ai) {
            u32x4 bw[4][2], pw[4][2];
#pragma unroll
            for (int m = 0; m < 4; ++m)
#pragma unroll
                for (int bj = 0; bj < 2; ++bj) {
                    const size_t off = (size_t)(row0 + ai * HALF + m * 16) * 1024 + col0 + bj * HALF;
                    bw[m][bj] = *(const u32x4*)(baseb + off); pw[m][bj] = *(const u32x4*)(pp + off);
                }
#pragma unroll
            for (int m = 0; m < 4; ++m) {
                const int row = row0 + ai * HALF + m * 16; float sq = 0.f;
                const float rs = __builtin_amdgcn_rsqf(rsv[ai * 4 + m] * (1.0f / 1024.0f) + 1e-6f) * (-1.4426950408889634f);
#pragma unroll
                for (int bj = 0; bj < 2; ++bj) {
                    const size_t off = (size_t)row * 1024 + col0 + bj * HALF;
                    f32x4 p0, p1, b0, b1;
                    unpack8(pw[m][bj], p0, p1); unpack8(bw[m][bj], b0, b1);
                    f32x4 v0, v1;
#pragma unroll
                    for (int e = 0; e < 4; ++e) {
                        const float g0 = __builtin_amdgcn_rcpf(1.0f + __builtin_amdgcn_exp2f(acc[ai][bj][m][0][e] * rs));
                        const float g1 = __builtin_amdgcn_rcpf(1.0f + __builtin_amdgcn_exp2f(acc[ai][bj][m][1][e] * rs));
                        v0[e] = b0[e] + p0[e] * g0; v1[e] = b1[e] + p1[e] * g1;
                    }
                    u32x4 w; w.x = cvt_pk_bf16(v0[0], v0[1]); w.y = cvt_pk_bf16(v0[2], v0[3]); w.z = cvt_pk_bf16(v1[0], v1[1]); w.w = cvt_pk_bf16(v1[2], v1[3]); *(u32x4*)(hb + off) = w;
                    sq += (v0[0] * v0[0] + v0[1] * v0[1]) + (v0[2] * v0[2] + v0[3] * v0[3]) + (v1[0] * v1[0] + v1[1] * v1[1]) + (v1[2] * v1[2] + v1[3] * v1[3]);
                }
                sq += __shfl_xor(sq, 16); sq += __shfl_xor(sq, 32);
                if (fq == 0) unsafeAtomicAdd(ss_out + row, sq);
            }
        }
    }
};
template <class Epi, class Sched, bool ALIGN_EPI = false, bool SP2 = false>
__device__ __forceinline__ void gemm_phase(PG8_LAS unsigned char* lds, const Gemm g, const Sched& S, const Epi& E) {
    int tid_ = threadIdx.x; asm volatile("" : "+v"(tid_));
    const int tid = tid_, wid = __builtin_amdgcn_readfirstlane(tid >> 6), lane = tid & 63, wr = wid >> 2, wc = wid & 3, fr = lane & 15, fq = lane >> 4;
    const int K = g.K, nt = K / BK;
    unsigned voffA[2], voffB[2];
#pragma unroll
    for (int i = 0; i < 2; ++i) { int R, C; stage_rc(tid * 16 + i * 8192, R, C); const int Rb = Epi::PERM ? ((R & ~31) + perm32(R & 31)) : R;
        voffA[i] = (unsigned)(R * K + C) * 2u; voffB[i] = (unsigned)(Rb * K + C) * 2u; }
    const size_t kstep = (size_t)(BK * 2);
    const size_t hstep = (size_t)HALF * K * 2;
    const size_t tstep = 2 * hstep;
    const unsigned ldsw = (unsigned)wid * 1024u;
    const int aoff = lds_byte(wr * 64 + fr, fq * 8), boff = lds_byte(wc * 32 + fr, fq * 8);
#define PG8_SA(b, h) (((b) * 2 + (h)) * HTB)
#define PG8_SB(b, h) ((4 + (b) * 2 + (h)) * HTB)
#define PG8_STAGE(bufoff, gbase, voff) do { _Pragma("unroll") for (int _i = 0; _i < 2; ++_i) \
        __builtin_amdgcn_global_load_lds((const unsigned*)((const char*)(gbase) + (voff)[_i]), (PG8_LAS unsigned*)(lds + (bufoff) + ldsw + _i * 8192), 16, 0, 0); } while (0)
#define PG8_LDA(dst, b, h) do { _Pragma("unroll") for (int m = 0; m < 4; ++m) _Pragma("unroll") for (int k = 0; k < 2; ++k) dst[m][k] = *(const PG8_LAS bf16x8*)(lds + PG8_SA(b, h) + aoff + m * 2048 + k * 1024); } while (0)
#define PG8_LDB(dst, b, h) do { _Pragma("unroll") for (int n = 0; n < 2; ++n) _Pragma("unroll") for (int k = 0; k < 2; ++k) dst[n][k] = *(const PG8_LAS bf16x8*)(lds + PG8_SB(b, h) + boff + n * 2048 + k * 1024); } while (0)
#define PG8_MMA(ai, bj, At, Bt) do { __builtin_amdgcn_s_setprio(1); _Pragma("unroll") for (int m = 0; m < 4; ++m) _Pragma("unroll") for (int n = 0; n < 2; ++n) _Pragma("unroll") for (int k = 0; k < 2; ++k) \
        acc[ai][bj][m][n] = __builtin_amdgcn_mfma_f32_16x16x32_bf16(Bt[n][k], At[m][k], acc[ai][bj][m][n], 0, 0, 0); __builtin_amdgcn_s_setprio(0); } while (0)
#define PG8_WAIT_V(n) asm volatile("s_waitcnt vmcnt(" #n ")" ::: "memory")
#define PG8_WAIT_L(n) asm volatile("s_waitcnt lgkmcnt(" #n ")" ::: "memory")
#define PG8_BAR __builtin_amdgcn_s_barrier()
#define PG8_SCHED __builtin_amdgcn_sched_barrier(0)
    Unit cur, nxt; int ui = 0;
    if (!S.next(0, cur)) return;
    f32x4 acc[2][2][4][2];
#pragma unroll
    for (int a = 0; a < 2; ++a)
#pragma unroll
        for (int b = 0; b < 2; ++b)
#pragma unroll
            for (int m = 0; m < 4; ++m)
#pragma unroll
                for (int n = 0; n < 2; ++n) acc[a][b][m][n] = (f32x4){0.f, 0.f, 0.f, 0.f};
    bf16x8 At[4][2], B0[2][2], B1[2][2];
    const char* cA = (const char*)g.A + (size_t)cur.pm * tstep; const char* cB = (const char*)g.Bt + (size_t)cur.pn * tstep;
    S.a_ready(cur);
    if constexpr (SP2) {
        PG8_STAGE(PG8_SB(0, 0), cB, voffB); PG8_STAGE(PG8_SB(0, 1), cB + hstep, voffB); PG8_STAGE(PG8_SA(0, 0), cA, voffA); PG8_STAGE(PG8_SA(0, 1), cA + hstep, voffA);
        if (wr == 1) PG8_BAR;
        PG8_WAIT_V(2); PG8_BAR;
        PG8_STAGE(PG8_SB(1, 0), cB + kstep, voffB); PG8_STAGE(PG8_SA(1, 0), cA + kstep, voffA); PG8_STAGE(PG8_SB(1, 1), cB + hstep + kstep, voffB);
        PG8_WAIT_V(6); PG8_BAR;
    } else {
        PG8_STAGE(PG8_SB(0, 0), cB, voffB); PG8_STAGE(PG8_SA(0, 0), cA, voffA); PG8_STAGE(PG8_SB(0, 1), cB + hstep, voffB); PG8_STAGE(PG8_SA(0, 1), cA + hstep, voffA);
        if (wr == 1) PG8_BAR;
        PG8_WAIT_V(4); PG8_BAR;
        PG8_STAGE(PG8_SB(1, 0), cB + kstep, voffB); PG8_STAGE(PG8_SA(1, 0), cA + kstep, voffA); PG8_STAGE(PG8_SB(1, 1), cB + hstep + kstep, voffB);
        PG8_WAIT_V(6); PG8_BAR;
    }
    for (;;) {
        const bool has_next = S.next(ui + 1, nxt);
        const char* nA = has_next ? (const char*)g.A + (size_t)nxt.pm * tstep : cA; const char* nB = has_next ? (const char*)g.Bt + (size_t)nxt.pn * tstep : cB;
        for (int t = 0; t < nt; t += 2) {
            const bool last = (t == nt - 2);
            const char* a1 = cA + (size_t)(t + 1) * kstep;
            const char* a2 = last ? nA : cA + (size_t)(t + 2) * kstep; const char* b2 = last ? nB : cB + (size_t)(t + 2) * kstep;
            const char* a3 = a2 + kstep; const char* b3 = b2 + kstep;
            if (last && has_next) S.a_ready(nxt);
            if constexpr (SP2) {
            PG8_LDB(B0, 0, 0); PG8_LDB(B1, 0, 1); PG8_SCHED; PG8_LDA(At, 0, 0); PG8_STAGE(PG8_SA(1, 1), a1 + hstep, voffA);
            PG8_WAIT_V(8); PG8_WAIT_L(0); PG8_BAR; PG8_MMA(0, 0, At, B0); PG8_MMA(0, 1, At, B1); PG8_BAR; PG8_SCHED;
            PG8_LDA(At, 0, 1); PG8_STAGE(PG8_SB(0, 0), b2, voffB); PG8_STAGE(PG8_SB(0, 1), b2 + hstep, voffB); PG8_STAGE(PG8_SA(0, 0), a2, voffA);
            PG8_WAIT_V(8); PG8_WAIT_L(0); PG8_BAR; PG8_MMA(1, 0, At, B0); PG8_MMA(1, 1, At, B1); PG8_BAR; PG8_SCHED;
            PG8_LDB(B0, 1, 0); PG8_LDB(B1, 1, 1); PG8_SCHED; PG8_LDA(At, 1, 0); PG8_STAGE(PG8_SA(0, 1), a2 + hstep, voffA);
            PG8_WAIT_V(8); PG8_WAIT_L(0); PG8_BAR; PG8_MMA(0, 0, At, B0); PG8_MMA(0, 1, At, B1); PG8_BAR; PG8_SCHED;
            PG8_LDA(At, 1, 1); PG8_STAGE(PG8_SB(1, 0), b3, voffB); PG8_STAGE(PG8_SB(1, 1), b3 + hstep, voffB); PG8_STAGE(PG8_SA(1, 0), a3, voffA);
            PG8_WAIT_V(8); PG8_WAIT_L(0); PG8_BAR; PG8_MMA(1, 0, At, B0); PG8_MMA(1, 1, At, B1); PG8_BAR; PG8_SCHED;
            } else {
            PG8_LDB(B0, 0, 0); PG8_SCHED; PG8_LDA(At, 0, 0); PG8_STAGE(PG8_SA(1, 1), a1 + hstep, voffA);
            PG8_WAIT_L(8); PG8_BAR; PG8_WAIT_L(0); PG8_MMA(0, 0, At, B0); PG8_BAR; PG8_SCHED;
            PG8_LDB(B1, 0, 1); PG8_STAGE(PG8_SB(0, 0), b2, voffB);
            PG8_BAR; PG8_WAIT_L(0); PG8_MMA(0, 1, At, B1); PG8_BAR;
            PG8_LDA(At, 0, 1); PG8_STAGE(PG8_SA(0, 0), a2, voffA);
            PG8_BAR; PG8_WAIT_L(0); PG8_MMA(1, 0, At, B0); PG8_BAR; PG8_SCHED;
            PG8_STAGE(PG8_SB(0, 1), b2 + hstep, voffB);
            PG8_WAIT_V(6); PG8_BAR; PG8_MMA(1, 1, At, B1); PG8_BAR;
            PG8_LDB(B0, 1, 0); PG8_SCHED; PG8_LDA(At, 1, 0); PG8_STAGE(PG8_SA(0, 1), a2 + hstep, voffA);
            PG8_WAIT_L(8); PG8_BAR; PG8_WAIT_L(0); PG8_MMA(0, 0, At, B0); PG8_BAR; PG8_SCHED;
            PG8_LDB(B1, 1, 1); PG8_STAGE(PG8_SB(1, 0), b3, voffB);
            PG8_BAR; PG8_WAIT_L(0); PG8_MMA(0, 1, At, B1); PG8_BAR;
            PG8_LDA(At, 1, 1); PG8_STAGE(PG8_SA(1, 0), a3, voffA);
            PG8_BAR; PG8_WAIT_L(0); PG8_MMA(1, 0, At, B0); PG8_BAR; PG8_SCHED;
            PG8_STAGE(PG8_SB(1, 1), b3 + hstep, voffB);
            PG8_WAIT_V(6); PG8_BAR; PG8_MMA(1, 1, At, B1); PG8_BAR;
            }
        }
        if constexpr (ALIGN_EPI) { if (wr == 0) PG8_BAR; }
        if constexpr (!Epi::AFTER_DRAIN) { E(acc, cur, wr, wc, fr, fq); S.done(cur); }
        if (!has_next) break;
#pragma unroll
        for (int a = 0; a < 2; ++a)
#pragma unroll
            for (int b = 0; b < 2; ++b)
#pragma unroll
                for (int m = 0; m < 4; ++m)
#pragma unroll
                    for (int n = 0; n < 2; ++n) acc[a][b][m][n] = (f32x4){0.f, 0.f, 0.f, 0.f};
        cur = nxt; cA = nA; cB = nB; ++ui;
        if constexpr (ALIGN_EPI) { if (wr == 1) PG8_BAR; }
    }
    PG8_WAIT_V(0);
    if constexpr (!ALIGN_EPI) { if (wr == 0) PG8_BAR; }
    PG8_BAR;
    if constexpr (Epi::AFTER_DRAIN) { E.fused(acc, cur, wr, wc, fr, fq, lds, wid, lane); S.done(cur); }
#undef PG8_SA
#undef PG8_SB
#undef PG8_STAGE
#undef PG8_LDA
#undef PG8_LDB
#undef PG8_MMA
#undef PG8_WAIT_V
#undef PG8_WAIT_L
#undef PG8_BAR
#undef PG8_SCHED
}
}
constexpr int NB = 8, SEQ = 8192, DM = 1024, MTOK = NB * SEQ, NPROJ = 3072, DFF = 4096, PLED = 256;
constexpr float LOG2E = 1.4426950408889634f, LN2 = 0.6931471805599453f;
constexpr int LUTS = 132;

namespace att {
#define LAS __attribute__((address_space(3)))
#define DI __device__ __forceinline__
typedef unsigned short bf16_t;
typedef short bf16x8 __attribute__((ext_vector_type(8)));
typedef short s16x4 __attribute__((ext_vector_type(4)));
typedef short v4i16_t __attribute__((ext_vector_type(4)));
typedef float f32x16 __attribute__((ext_vector_type(16)));
typedef float f32x4 __attribute__((ext_vector_type(4)));
typedef unsigned u32x4 __attribute__((ext_vector_type(4)));
typedef unsigned u32x2 __attribute__((ext_vector_type(2)));
typedef float f32x2_t __attribute__((ext_vector_type(2)));
typedef __bf16 bf16x2_t __attribute__((ext_vector_type(2)));
typedef LAS unsigned char* lp;
#define MFMA32(a, b, c) __builtin_amdgcn_mfma_f32_32x32x16_bf16((a), (b), (c), 0, 0, 0)
constexpr float NEGBIG = -1.0e30f;

DI int crow(int r, int h) { return (r & 3) + 8 * (r >> 2) + 4 * h; }
constexpr int PP = 256;
DI size_t pcol(int c) { return (size_t)(c >> 8) * ((size_t)MTOK * 256) + (size_t)(c & 255); }
DI unsigned cvtpk(float lo, float hi) { f32x2_t v = {lo, hi}; bf16x2_t b = __builtin_convertvector(v, bf16x2_t); return __builtin_bit_cast(unsigned, b); }
template <int S> DI bf16x8 pack8(const f32x16& x) {
    u32x4 p; p.x = cvtpk(x[8 * S], x[8 * S + 1]); p.y = cvtpk(x[8 * S + 2], x[8 * S + 3]); p.z = cvtpk(x[8 * S + 4], x[8 * S + 5]); p.w = cvtpk(x[8 * S + 6], x[8 * S + 7]);
    return __builtin_bit_cast(bf16x8, p);
}
DI s16x4 trd(lp p) { return __builtin_bit_cast(s16x4, __builtin_amdgcn_ds_read_tr16_b64_v4i16((LAS v4i16_t*)p)); }
template <int HI> DI bf16x8 vfrag(lp p) { const s16x4 lo = trd(p), hi = trd(p + HI); return __builtin_shufflevector(lo, hi, 0, 1, 2, 3, 4, 5, 6, 7); }
DI f32x16 zero16() { f32x16 z;
#pragma unroll
    for (int i = 0; i < 16; ++i) z[i] = 0.f; return z; }
DI float hmax16(const f32x16& p) { float a = fmaxf(fmaxf(p[0], p[1]), fmaxf(p[2], p[3]));
#pragma unroll
    for (int i = 4; i < 16; i += 4) a = fmaxf(a, fmaxf(fmaxf(p[i], p[i + 1]), fmaxf(p[i + 2], p[i + 3]))); return a; }
DI float hsum16(const f32x16& p) { float a = (p[0] + p[1]) + (p[2] + p[3]);
#pragma unroll
    for (int i = 4; i < 16; i += 4) a += (p[i] + p[i + 1]) + (p[i + 2] + p[i + 3]); return a; }

constexpr float SB_STOP = 26.0f;
DI void sb_unit(int b, int hs, int qb, const bf16_t* proj, bf16_t* obuf, lp lds) {
    constexpr int KS = 144, KBUF = 64 * KS, VBUF = 64 * 128, VOFF = 2 * KBUF, FOFF = VOFF + 2 * VBUF;
    int tid_ = threadIdx.x; asm volatile("" : "+v"(tid_));
    const int tid = tid_, lane = tid & 63, r = lane & 31, h = lane >> 5, wid = __builtin_amdgcn_readfirstlane(tid >> 6);
    const size_t rowbase = (size_t)b * SEQ; const int q0 = qb * 256, q0w = q0 + wid * 32, myq = q0w + r;
    bf16x8 qf[4];
    { const bf16_t* Qp = proj + pcol(hs * 64) + (rowbase + myq) * PP + 8 * h;
#pragma unroll
      for (int s = 0; s < 4; ++s) qf[s] = *(const bf16x8*)(Qp + 16 * s); }
    const int srow = tid >> 3, sc = tid & 7, soff = srow * KS + sc * 16, svoff = (srow >> 3) * 1024 + (sc >> 2) * 512 + (srow & 7) * 64 + (sc & 3) * 16;
    const bf16_t* Kg = proj + pcol(512 + hs * 64) + (rowbase + srow) * PP + sc * 8;
    const bf16_t* Vg = proj + pcol(1024 + hs * 64) + (rowbase + srow) * PP + sc * 8;
    bf16x8 T0, T1, ONES;
#pragma unroll
    for (int j = 0; j < 8; ++j) { const int k0 = 8 * (j >> 2) + 4 * h + (j & 3); T0[j] = (k0 >= r) ? (short)0x3F80 : (short)0; T1[j] = (16 + k0 >= r) ? (short)0x3F80 : (short)0; ONES[j] = (short)0x3F80; }
    f32x16 O0 = zero16(), O1 = zero16(); float carry = 0.f; bool wdone = false;
    const int NT = (q0 + 256) / 64;
    LAS unsigned* flags = (LAS unsigned*)(lds + FOFF);
    const int vlane = (4 * h + ((lane & 15) >> 2)) * 64 + ((lane >> 4) & 1) * 32 + (lane & 3) * 8;
    u32x4 kreg, vreg;
    int t = NT - 1;
    kreg = *(const u32x4*)(Kg + (size_t)(64 * t) * PP); vreg = *(const u32x4*)(Vg + (size_t)(64 * t) * PP);
    *(LAS u32x4*)(lds + soff) = kreg; *(LAS u32x4*)(lds + VOFF + svoff) = vreg;
    __syncthreads();
    asm volatile("" : "+v"(qf[0]), "+v"(qf[1]), "+v"(qf[2]), "+v"(qf[3]));
    int buf = 0;
    for (; t >= 0; --t) {
        if (t > 0) { kreg = *(const u32x4*)(Kg + (size_t)(64 * (t - 1)) * PP); vreg = *(const u32x4*)(Vg + (size_t)(64 * (t - 1)) * PP); }
        const int kvb = 64 * t;
        if (kvb <= q0w + 30 && !wdone) {
            const lp Kb = lds + buf * KBUF, Vb = lds + VOFF + buf * VBUF;
            f32x16 p0 = zero16(), p1 = zero16();
#pragma unroll
            for (int s = 0; s < 4; ++s) {
                const bf16x8 a0 = *(const LAS bf16x8*)(Kb + r * KS + s * 32 + h * 16), a1 = *(const LAS bf16x8*)(Kb + (32 + r) * KS + s * 32 + h * 16);
                p0 = MFMA32(a0, qf[s], p0); p1 = MFMA32(a1, qf[s], p1);
            }
            f32x16 sp0, sp1;
#pragma unroll
            for (int i = 0; i < 16; ++i) {
                const int kv = kvb + crow(i, h);
                { const float z = p0[i] * 0.125f, e = __builtin_amdgcn_exp2f(-fabsf(z) * LOG2E), sp = fmaxf(z, 0.f) + __builtin_amdgcn_logf(1.0f + e) * LN2; sp0[i] = (kv < myq) ? sp : 0.f; p0[i] = z; }
                { const float z = p1[i] * 0.125f, e = __builtin_amdgcn_exp2f(-fabsf(z) * LOG2E), sp = fmaxf(z, 0.f) + __builtin_amdgcn_logf(1.0f + e) * LN2; sp1[i] = (kv + 32 < myq) ? sp : 0.f; p1[i] = z; }
            }
            const bf16x8 sk0 = pack8<0>(sp0), sk1 = pack8<1>(sp0), sk2 = pack8<0>(sp1), sk3 = pack8<1>(sp1);
            f32x16 C0 = zero16(), C1 = zero16();
            C0 = MFMA32(T0, sk0, C0); C0 = MFMA32(T1, sk1, C0); C0 = MFMA32(ONES, sk2, C0); C0 = MFMA32(ONES, sk3, C0);
            C1 = MFMA32(T0, sk2, C1); C1 = MFMA32(T1, sk3, C1);
            const float tot = __shfl(C0[0], r);
#pragma unroll
            for (int i = 0; i < 16; ++i) {
                const int kv = kvb + crow(i, h);
                p0[i] = (kv < myq) ? __builtin_amdgcn_exp2f((p0[i] - C0[i] - carry) * LOG2E) : 0.f;
                p1[i] = (kv + 32 < myq) ? __builtin_amdgcn_exp2f((p1[i] - C1[i] - carry) * LOG2E) : 0.f;
            }
            carry += tot;
            const bf16x8 w0 = pack8<0>(p0), w1 = pack8<1>(p0), w2 = pack8<0>(p1), w3 = pack8<1>(p1);
            const lp vb = Vb + vlane;
            bf16x8 vf[8];
#pragma unroll
            for (int s = 0; s < 4; ++s) { vf[2 * s] = vfrag<1024>(vb + s * 2048); vf[2 * s + 1] = vfrag<1024>(vb + s * 2048 + 512); }
            __builtin_amdgcn_sched_barrier(0);
            O0 = MFMA32(vf[0], w0, O0); O1 = MFMA32(vf[1], w0, O1);
            O0 = MFMA32(vf[2], w1, O0); O1 = MFMA32(vf[3], w1, O1);
            O0 = MFMA32(vf[4], w2, O0); O1 = MFMA32(vf[5], w2, O1);
            O0 = MFMA32(vf[6], w3, O0); O1 = MFMA32(vf[7], w3, O1);
            wdone = __all(carry > SB_STOP) != 0;
        }
        if (t > 0) { *(LAS u32x4*)(lds + (buf ^ 1) * KBUF + soff) = kreg; *(LAS u32x4*)(lds + VOFF + (buf ^ 1) * VBUF + svoff) = vreg; }
        if (lane == 0) flags[(t & 1) * 8 + wid] = wdone ? 1u : 0u;
        __syncthreads();
        unsigned alld = 1u;
#pragma unroll
        for (int w = 0; w < 8; ++w) alld &= flags[(t & 1) * 8 + w];
        if (alld) break;
        buf ^= 1;
    }
    bf16_t* Op = obuf + (rowbase + myq) * DM + hs * 64 + 4 * h;
#pragma unroll
    for (int g = 0; g < 4; ++g) {
        u32x2 a; a.x = cvtpk(O0[4 * g], O0[4 * g + 1]); a.y = cvtpk(O0[4 * g + 2], O0[4 * g + 3]); *(u32x2*)(Op + 8 * g) = a;
        u32x2 c; c.x = cvtpk(O1[4 * g], O1[4 * g + 1]); c.y = cvtpk(O1[4 * g + 2], O1[4 * g + 3]); *(u32x2*)(Op + 32 + 8 * g) = c;
    }
    __syncthreads();
}

DI void diff_unit(int b, int hd, int qb, const bf16_t* proj, bf16_t* obuf, const float* lutg, float lam, const float* subg, lp lds, int ntcap = 1 << 30, int mode = 0) {
    constexpr int KS = 272, KBUF = 128 * KS, VBUF = 128 * 256, VOFF = 2 * KBUF, LOFF = VOFF + 2 * VBUF;
    int tid_ = threadIdx.x; asm volatile("" : "+v"(tid_));
    const int tid = tid_, lane = tid & 63, r = lane & 31, h = lane >> 5, wid = __builtin_amdgcn_readfirstlane(tid >> 6);
    const int map = wid >> 2, wq = wid & 3;
    const size_t rowbase = (size_t)b * SEQ; const int q0 = qb * 128, q0w = q0 + wq * 32, myq = q0w + r;
    LAS float* lutS = (LAS float*)(lds + LOFF);
    if (tid < 2 * LUTS) lutS[tid] = lutg[(8 + 2 * hd) * LUTS + tid];
    LAS float* subS = lutS + 2 * LUTS;
    if (tid >= 384 && tid < 512) subS[tid - 384] = subg[tid - 384];
    const LAS float* mylut = lutS + map * LUTS;
    bf16x8 qf[4];
    { const bf16_t* Qp = proj + pcol(1536 + hd * 128 + map * 64) + (rowbase + myq) * PP + 8 * h;
#pragma unroll
      for (int s = 0; s < 4; ++s) qf[s] = *(const bf16x8*)(Qp + 16 * s); }
    const int srow = tid >> 4, sc = tid & 15, soff = srow * KS + sc * 16, svoff = (srow >> 3) * 2048 + (sc >> 2) * 512 + (srow & 7) * 64 + (sc & 3) * 16;
    const unsigned toffK = (unsigned)(srow * PP + sc * 8), toffV = toffK + (unsigned)(pcol(2560 + hd * 128) - pcol(2048 + hd * 128));
    const bf16_t* const Kg = proj + pcol(2048 + hd * 128) + rowbase * PP;
    const int vlane = (4 * h + ((lane & 15) >> 2)) * 64 + ((lane >> 4) & 1) * 32 + (lane & 3) * 8;
    const float c2 = 0.125f * LOG2E;
    f32x16 O[4];
#pragma unroll
    for (int d = 0; d < 4; ++d) O[d] = zero16();
    float mrun = NEGBIG, lrun = 0.f;
    const int NT = min(qb + 1, ntcap);
#define DEXP(x) ((mode == 2) ? (x) : __builtin_amdgcn_exp2f(x))
#define DPV(A_, B_, C_) ((mode == 3) ? (C_) : MFMA32(A_, B_, C_))
    u32x4 kr[4];
#pragma unroll
    for (int j = 0; j < 4; ++j) kr[j] = *(const u32x4*)(Kg + (size_t)(32 * j) * PP + toffK);
#pragma unroll
    for (int j = 0; j < 4; ++j) *(LAS u32x4*)(lds + soff + 32 * j * KS) = kr[j];
#pragma unroll
    for (int j = 0; j < 4; ++j) kr[j] = *(const u32x4*)(Kg + (size_t)(32 * j) * PP + toffV);
#pragma unroll
    for (int j = 0; j < 4; ++j) *(LAS u32x4*)(lds + VOFF + svoff + 8192 * j) = kr[j];
    __syncthreads();
    asm volatile("" : "+v"(qf[0]), "+v"(qf[1]), "+v"(qf[2]), "+v"(qf[3]));
    int buf = 0;
#pragma unroll 1
    for (int t = 0; t < NT; ++t) {
        const size_t go = (size_t)(128 * (t + 1)) * PP;
        if (t + 1 < NT) {
#pragma unroll
            for (int j = 0; j < 4; ++j) kr[j] = *(const u32x4*)(Kg + go + (size_t)(32 * j) * PP + toffK); }
        if (mode == 1) {
            if (t + 1 < NT) {
#pragma unroll
                for (int j = 0; j < 4; ++j) *(LAS u32x4*)(lds + (buf ^ 1) * KBUF + soff + 32 * j * KS) = kr[j];
#pragma unroll
                for (int j = 0; j < 4; ++j) kr[j] = *(const u32x4*)(Kg + go + (size_t)(32 * j) * PP + toffV);
#pragma unroll
                for (int j = 0; j < 4; ++j) *(LAS u32x4*)(lds + VOFF + (buf ^ 1) * VBUF + svoff + 8192 * j) = kr[j]; }
            lrun = 1.0f;
        } else {
            const lp Kb0 = lds + buf * KBUF + map * 128 + r * KS + h * 16, Vb0 = lds + VOFF + buf * VBUF + vlane;
            const int kv0 = 128 * t;
            f32x16 a0, a1, b0, b1;
            bf16x8 w0, w1, w2, w3, x0, x1, x2, x3; float alpha0, alpha1;
#define DIFF_BIAS(P0, P1, KVB, SC, BI) do { \
            if ((KVB) + 63 + 128 <= q0w) { SC = c2; BI = mylut[128];     \
            } else { SC = 1.0f; BI = 0.0f; \
                _Pragma("unroll") for (int i = 0; i < 16; ++i) { \
                    const int d0_ = myq - ((KVB) + crow(i, h)), d1_ = d0_ - 32; \
                    const float l0_ = mylut[min(max(d0_, 0), 128)], l1_ = mylut[min(max(d1_, 0), 128)]; \
                    P0[i] = (d0_ >= 0) ? P0[i] * c2 + l0_ : NEGBIG; P1[i] = (d1_ >= 0) ? P1[i] * c2 + l1_ : NEGBIG; \
                    if ((i & 3) == 3) __builtin_amdgcn_sched_barrier(0); } } } while (0)
            __builtin_amdgcn_s_setprio(1);
            { bf16x8 k0[4];
#pragma unroll
              for (int s = 0; s < 4; ++s) k0[s] = *(const LAS bf16x8*)(Kb0 + s * 32);
              a0 = MFMA32(k0[0], qf[0], zero16());
#pragma unroll
              for (int s = 1; s < 4; ++s) a0 = MFMA32(k0[s], qf[s], a0);
              __builtin_amdgcn_sched_barrier(0);
#pragma unroll
              for (int s = 0; s < 4; ++s) k0[s] = *(const LAS bf16x8*)(Kb0 + 32 * KS + s * 32);
              a1 = MFMA32(k0[0], qf[0], zero16());
#pragma unroll
              for (int s = 1; s < 4; ++s) a1 = MFMA32(k0[s], qf[s], a1); }
            float sca, bia, scb, bib;
            __builtin_amdgcn_s_setprio(0);
            DIFF_BIAS(a0, a1, kv0, sca, bia);
            __builtin_amdgcn_sched_barrier(0);
            bf16x8 vr[4][2];
#define VOFFP(p) ((((p) >> 3) * 16384) + ((((p) & 7) >> 1) * 512) + (((p) & 1) * 8192))
#define VLOAD(p) do { vr[(p) & 3][0] = vfrag<2048>(Vb0 + VOFFP(p)); vr[(p) & 3][1] = vfrag<2048>(Vb0 + VOFFP(p) + 4096); } while (0)
            {
              bf16x8 k0[4];
#pragma unroll
              for (int s = 0; s < 4; ++s) k0[s] = *(const LAS bf16x8*)(Kb0 + 64 * KS + s * 32);
              b0 = MFMA32(k0[0], qf[0], zero16());
#pragma unroll
              for (int s = 1; s < 4; ++s) b0 = MFMA32(k0[s], qf[s], b0);
              float mx = fmaxf(hmax16(a0), hmax16(a1)); float mnew = mrun;
              if (__any(mx * sca + bia > mrun + 8.0f)) { mx = fmaxf(mx, __shfl_xor(mx, 32)); const float cnd0 = mx * sca + bia; mnew = (cnd0 > mrun + 8.0f) ? cnd0 : mrun; }     alpha0 = __builtin_amdgcn_exp2f(mrun - mnew); const float offa = bia - mnew;
#pragma unroll
              for (int i = 0; i < 16; ++i) a0[i] = DEXP(a0[i] * sca + offa);
              w0 = pack8<0>(a0); w1 = pack8<1>(a0);
              const float s0 = hsum16(a0);
              __builtin_amdgcn_sched_barrier(0);
#pragma unroll
              for (int s = 0; s < 4; ++s) k0[s] = *(const LAS bf16x8*)(Kb0 + 96 * KS + s * 32);
              b1 = MFMA32(k0[0], qf[0], zero16());
#pragma unroll
              for (int s = 1; s < 4; ++s) b1 = MFMA32(k0[s], qf[s], b1);
#pragma unroll
              for (int i = 0; i < 16; ++i) a1[i] = DEXP(a1[i] * sca + offa);
              w2 = pack8<0>(a1); w3 = pack8<1>(a1);
              lrun = lrun * alpha0 + (s0 + hsum16(a1)); mrun = mnew; }
            __builtin_amdgcn_sched_barrier(0);
            VLOAD(0);
            if (__any(alpha0 != 1.0f)) {
#pragma unroll
                for (int d = 0; d < 4; ++d) O[d] = O[d] * alpha0; }
            if (t + 1 < NT) {
#pragma unroll
                for (int j = 0; j < 4; ++j) *(LAS u32x4*)(lds + (buf ^ 1) * KBUF + soff + 32 * j * KS) = kr[j];
#pragma unroll
                for (int j = 0; j < 4; ++j) kr[j] = *(const u32x4*)(Kg + go + (size_t)(32 * j) * PP + toffV); }
            DIFF_BIAS(b0, b1, kv0 + 64, scb, bib);
            __builtin_amdgcn_s_setprio(1);
            __builtin_amdgcn_sched_barrier(0);
            {
                float mx = fmaxf(hmax16(b0), hmax16(b1)); float mnew1 = mrun;
                if (__any(mx * scb + bib > mrun + 8.0f)) { mx = fmaxf(mx, __shfl_xor(mx, 32)); const float cnd1 = mx * scb + bib; mnew1 = (cnd1 > mrun + 8.0f) ? cnd1 : mrun; }
                const float off1 = bib - mnew1; alpha1 = __builtin_amdgcn_exp2f(mrun - mnew1);
                float sum1 = 0.f; unsigned xw[16];
                __builtin_amdgcn_sched_barrier(0);
#pragma unroll
                for (int j = 0; j < 16; ++j) {
                    if ((j & 1) == 0) VLOAD((j >> 1) + 1);
                    { const int i = j >> 1;
                      if (i & 1) O[i >> 1] = DPV(vr[i & 3][j & 1], (j & 1) ? w3 : w2, O[i >> 1]);
                      else       O[i >> 1] = DPV(vr[i & 3][j & 1], (j & 1) ? w1 : w0, O[i >> 1]); }
                    { float e0, e1;
                      if (j < 8) { e0 = DEXP(b0[2 * j] * scb + off1); e1 = DEXP(b0[2 * j + 1] * scb + off1); }
                      else       { e0 = DEXP(b1[2 * (j - 8)] * scb + off1); e1 = DEXP(b1[2 * (j - 8) + 1] * scb + off1); }
                      sum1 += e0 + e1; xw[j] = cvtpk(e0, e1);
                      asm volatile("" : "+v"(xw[j]), "+v"(sum1)); }
                    __builtin_amdgcn_sched_barrier(0);
                }
                { u32x4 t0 = {xw[0], xw[1], xw[2], xw[3]}, t1 = {xw[4], xw[5], xw[6], xw[7]}, t2 = {xw[8], xw[9], xw[10], xw[11]}, t3 = {xw[12], xw[13], xw[14], xw[15]};
                  x0 = __builtin_bit_cast(bf16x8, t0); x1 = __builtin_bit_cast(bf16x8, t1); x2 = __builtin_bit_cast(bf16x8, t2); x3 = __builtin_bit_cast(bf16x8, t3); }
                lrun = lrun * alpha1 + sum1; mrun = mnew1; }
            if (__any(alpha1 != 1.0f)) {
#pragma unroll
                for (int d = 0; d < 4; ++d) O[d] = O[d] * alpha1; }
            VLOAD(9); VLOAD(10);
#pragma unroll
            for (int i = 0; i < 8; ++i) {
                if (i < 5) VLOAD(8 + i + 3);
                if (i & 1) { O[i >> 1] = DPV(vr[i & 3][0], x2, O[i >> 1]); O[i >> 1] = DPV(vr[i & 3][1], x3, O[i >> 1]); }
                else       { O[i >> 1] = DPV(vr[i & 3][0], x0, O[i >> 1]); O[i >> 1] = DPV(vr[i & 3][1], x1, O[i >> 1]); }
                __builtin_amdgcn_sched_barrier(0);
            }
            __builtin_amdgcn_s_setprio(0);
#undef VLOAD
#undef VOFFP
            if (t + 1 < NT) {
#pragma unroll
                for (int j = 0; j < 4; ++j) *(LAS u32x4*)(lds + VOFF + (buf ^ 1) * VBUF + svoff + 8192 * j) = kr[j]; }
#undef DIFF_BIAS
        }
        __syncthreads();
        buf ^= 1;
    }
#undef DEXP
#undef DPV
    lrun += __shfl_xor(lrun, 32);
    const float inv = 1.0f / lrun;
    LAS float* X = (LAS float*)lds;
    if (map == 1) {
#pragma unroll
        for (int d = 0; d < 4; ++d)
#pragma unroll
            for (int i = 0; i < 16; ++i) X[(wq * 64 + d * 16 + i) * 64 + lane] = O[d][i] * inv;
    }
    __syncthreads();
    if (map == 0) {
        float ssq = 0.f;
#pragma unroll
        for (int d = 0; d < 4; ++d)
#pragma unroll
            for (int i = 0; i < 16; ++i) { const float v = O[d][i] * inv - lam * X[(wq * 64 + d * 16 + i) * 64 + lane]; O[d][i] = v; ssq += v * v; }
        ssq += __shfl_xor(ssq, 32);
        const float rn = __builtin_amdgcn_rsqf(ssq * (1.0f / 128.0f) + 1e-5f) * 0.8f;
        const lp stg = lds + VOFF + (wq * 32 + r) * 272 + 8 * h;
#pragma unroll
        for (int d = 0; d < 4; ++d)
#pragma unroll
            for (int g = 0; g < 4; ++g) {
                const f32x4 gv = *(const LAS f32x4*)(subS + 32 * d + 8 * g + 4 * h);
                u32x2 a; a.x = cvtpk(O[d][4 * g] * rn * gv[0], O[d][4 * g + 1] * rn * gv[1]); a.y = cvtpk(O[d][4 * g + 2] * rn * gv[2], O[d][4 * g + 3] * rn * gv[3]);
                *(LAS u32x2*)(stg + (32 * d + 8 * g) * 2) = a;
            }
    }
    __syncthreads();
    { bf16_t* Ob = obuf + (rowbase + q0) * DM + 512 + hd * 128;
#pragma unroll
      for (int i = 0; i < 4; ++i) { const int p = wid * 64 + lane + 512 * i, row = p >> 4, c = p & 15;
          const u32x4 v = *(const LAS u32x4*)(lds + VOFF + row * 272 + c * 16);
          *(u32x4*)(Ob + (size_t)row * DM + c * 8) = v; } }
    __syncthreads();
}

struct DilState { f32x16 O0, O1; float m, l; bf16x8 qf[4]; };
constexpr int DKS = 144, DCH = 256 * DKS, DVB = 256 * 128, DVOFF = 2 * DCH, DLOFF = DVOFF + 2 * DVB;
constexpr int DL_OWN = 192, DL_OTH = 384;
DI void dil_pv(DilState& st, const f32x16& p, float alpha, const bf16x8 (&vf)[4]) {
    if (__any(alpha != 1.0f)) { st.O0 = st.O0 * alpha; st.O1 = st.O1 * alpha; }
    const bf16x8 w0 = pack8<0>(p), w1 = pack8<1>(p);
    st.O0 = MFMA32(vf[0], w0, st.O0); st.O1 = MFMA32(vf[1], w0, st.O1);
    st.O0 = MFMA32(vf[2], w1, st.O0); st.O1 = MFMA32(vf[3], w1, st.O1);
}
DI f32x16 dil_qk(const DilState& st, lp kb, lp vb, bf16x8 (&vf)[4]) {
    bf16x8 ka[4];
#pragma unroll
    for (int s = 0; s < 4; ++s) ka[s] = *(const LAS bf16x8*)(kb + s * 32);
    vf[0] = vfrag<1024>(vb); vf[1] = vfrag<1024>(vb + 512); vf[2] = vfrag<1024>(vb + 2048); vf[3] = vfrag<1024>(vb + 2048 + 512);
    __builtin_amdgcn_sched_barrier(0);
    f32x16 p = zero16();
#pragma unroll
    for (int s = 0; s < 4; ++s) p = MFMA32(ka[s], st.qf[s], p);
    return p;
}
DI void dil_tile_lut(DilState& st, lp kb, lp vb, const LAS float* lut, const int LSTEP  ) {
    bf16x8 vf[4];
    f32x16 p = dil_qk(st, kb, vb, vf);
    const float c2 = 0.125f * LOG2E;
#pragma unroll
    for (int i = 0; i < 16; ++i) { const int ci = (i & 3) + 8 * (i >> 2); p[i] = p[i] * c2 + lut[(27 - ci) * LSTEP]; }
    float mx = hmax16(p); float mnew = st.m;
    if (__any(mx > st.m + 8.0f)) { mx = fmaxf(mx, __shfl_xor(mx, 32)); mnew = (mx > st.m + 8.0f) ? mx : st.m; }
    const float alpha = __builtin_amdgcn_exp2f(st.m - mnew);
#pragma unroll
    for (int i = 0; i < 16; ++i) p[i] = __builtin_amdgcn_exp2f(p[i] - mnew);
    st.l = st.l * alpha + hsum16(p); st.m = mnew;
    dil_pv(st, p, alpha, vf);
}
DI void dil_tile_far(DilState& st, lp kb, lp vb, float b31, bool edge, int r, int h, const float (&me)[4]) {
    bf16x8 vf[4];
    f32x16 p = dil_qk(st, kb, vb, vf);
    const float c2 = 0.125f * LOG2E;
    const int e = r & 3;
    float v[4];
#pragma unroll
    for (int g = 0; g < 4; ++g) { const float x = (p[4 * g] * me[0] + p[4 * g + 1] * me[1]) + (p[4 * g + 2] * me[2] + p[4 * g + 3] * me[3]); v[g] = x * c2 + b31;
        if (edge && r > e + 8 * g + 4 * h) v[g] = NEGBIG; }
    float mx = fmaxf(fmaxf(v[0], v[1]), fmaxf(v[2], v[3])); float mnew = st.m;
    if (__any(mx > st.m + 8.0f)) { mx = fmaxf(mx, __shfl_xor(mx, 32)); mnew = (mx > st.m + 8.0f) ? mx : st.m; }
    const float alpha = __builtin_amdgcn_exp2f(st.m - mnew);
#pragma unroll
    for (int g = 0; g < 4; ++g) v[g] = __builtin_amdgcn_exp2f(v[g] - mnew);
    st.l = st.l * alpha + ((v[0] + v[1]) + (v[2] + v[3])); st.m = mnew;
#pragma unroll
    for (int g = 0; g < 4; ++g) { p[4 * g] = v[g] * me[0]; p[4 * g + 1] = v[g] * me[1]; p[4 * g + 2] = v[g] * me[2]; p[4 * g + 3] = v[g] * me[3]; }
    dil_pv(st, p, alpha, vf);
}
DI void dil_unit(int b, int head, int span, const bf16_t* proj, bf16_t* obuf, const float* lutg, lp lds) {
    int tid_ = threadIdx.x; asm volatile("" : "+v"(tid_));
    const int tid = tid_, lane = tid & 63, r = lane & 31, h = lane >> 5, wid = __builtin_amdgcn_readfirstlane(tid >> 6);
    const int pr = wid >> 2, c = wid & 3;
    const size_t rowbase = (size_t)b * SEQ; const int T0 = span * 512;
    LAS float* lutOwn = (LAS float*)(lds + DLOFF); LAS float* lutOth = lutOwn + DL_OWN;
    { const float* lg = lutg + head * LUTS;
      for (int i = tid; i < DL_OWN + DL_OTH; i += 512) {
          float val;
          if (i < DL_OWN) { const int d = 4 * (i - 31); const int mult = (d <= 128 ? 1 : 0) + (d <= 512 ? 1 : 0) + ((d & 15) == 0 ? 1 : 0);
              val = (d < 0 || mult == 0) ? NEGBIG : lg[min(d, 128)] + ((mult == 3) ? 1.5849625007211562f : ((mult == 2) ? 1.0f : 0.0f)); }
          else { const int d = (i - DL_OWN) - 127; val = (d >= 0 && d <= 128) ? lg[d] : NEGBIG; }
          lutOwn[i] = val; } }
    float b31 = lutg[head * LUTS + 128];
    float me[4];
#pragma unroll
    for (int e = 0; e < 4; ++e) me[e] = ((r & 3) == e) ? 1.0f : 0.0f;
    DilState st[2];
#pragma unroll
    for (int q = 0; q < 2; ++q) { st[q].O0 = zero16(); st[q].O1 = zero16(); st[q].m = NEGBIG; st[q].l = 0.f;
        const bf16_t* Qp = proj + pcol(head * 64) + (rowbase + T0 + 128 * (2 * pr + q) + c + 4 * r) * PP + 8 * h;
#pragma unroll
        for (int s = 0; s < 4; ++s) st[q].qf[s] = *(const bf16x8*)(Qp + 16 * s); }
    const int x0 = tid >> 3, sc = tid & 7;
    const int rho0 = (x0 & 3) * 32 + (x0 >> 2), soff = rho0 * DKS + sc * 16;
    const int svoff = (rho0 >> 3) * 1024 + (sc >> 2) * 512 + (rho0 & 7) * 64 + (sc & 3) * 16;
    const unsigned toffK = (unsigned)(x0 * PP + sc * 8), toffV = toffK + (unsigned)(4 * (size_t)MTOK * 256);
    const bf16_t* const ubase = proj + pcol(1024 + head * 64) + (rowbase + (size_t)T0) * PP - (size_t)2048 * PP;
    const int vlane = (4 * h + ((lane & 15) >> 2)) * 64 + ((lane >> 4) & 1) * 32 + (lane & 3) * 8;
    const int klane = r * DKS + h * 16;
    const int k0 = (T0 >= 2048) ? 0 : (2048 - T0) / 256, nk = 10 - k0;
    const int kst = max(k0, (10 - (2 * span) % 10) % 10);
#define DIL_K(i) (k0 + (kst - k0 + (i)) % nk)
    u32x4 kr[4];
    { const bf16_t* cb = ubase + (size_t)(256 * kst) * PP;
#pragma unroll
      for (int j = 0; j < 4; ++j) kr[j] = *(const u32x4*)(cb + (size_t)(64 * j) * PP + toffK);
#pragma unroll
      for (int j = 0; j < 4; ++j) { const int o = soff + ((j >> 1) * 128 + 16 * (j & 1)) * DKS; *(LAS u32x4*)(lds + o) = kr[j]; }
#pragma unroll
      for (int j = 0; j < 4; ++j) kr[j] = *(const u32x4*)(cb + (size_t)(64 * j) * PP + toffV);
#pragma unroll
      for (int j = 0; j < 4; ++j) *(LAS u32x4*)(lds + DVOFF + svoff + ((j >> 1) * 16 + 2 * (j & 1)) * 1024) = kr[j]; }
    __syncthreads();
    asm volatile("" : "+v"(b31), "+v"(me[0]), "+v"(me[1]), "+v"(me[2]), "+v"(me[3]));
#pragma unroll
    for (int q = 0; q < 2; ++q) asm volatile("" : "+v"(st[q].qf[0]), "+v"(st[q].qf[1]), "+v"(st[q].qf[2]), "+v"(st[q].qf[3]));
    int buf = 0;
#pragma unroll 1
    for (int ik = 0; ik < nk; ++ik) {
        const int k = DIL_K(ik);
        const bool more = ik + 1 < nk;
        const bf16_t* const cn = ubase + (size_t)(256 * DIL_K(ik + 1)) * PP;
        if (more) {
#pragma unroll
            for (int j = 0; j < 4; ++j) kr[j] = *(const u32x4*)(cn + (size_t)(64 * j) * PP + toffK); }
#pragma unroll 1
        for (int hc = 0; hc < 2; ++hc) {
            const lp Kh = lds + buf * DCH + hc * 128 * DKS + klane, Vh = lds + DVOFF + buf * DVB + hc * 16384 + vlane;
#pragma unroll
            for (int q = 0; q < 2; ++q) {
                const int ch = 2 * k + hc - (2 * pr + q);
                if (ch < 0 || ch > 16) continue;
                if (ch <= 11) { dil_tile_far(st[q], Kh + c * 32 * DKS, Vh + c * 4096, b31, ch == 0, r, h, me); }
                else {
                    const int delta = 2048 - 128 * ch;
                    dil_tile_lut(st[q], Kh + c * 32 * DKS, Vh + c * 4096, lutOwn + (delta / 4 + r + 4 - 4 * h), 1);
                    if (ch >= 15) {
#pragma unroll 1
                        for (int cc = 1; cc < 4; ++cc) { const int cls = (c + cc) & 3;
                            dil_tile_lut(st[q], Kh + cls * 32 * DKS, Vh + cls * 4096, lutOth + (delta + (c - cls) + 4 * r + 19 - 16 * h), 4); }
                    }
                }
            }
            if (more) {
#pragma unroll
                for (int j = 0; j < 4; ++j) {
                    if (hc == 0) *(LAS u32x4*)(lds + (buf ^ 1) * DCH + soff + ((j >> 1) * 128 + 16 * (j & 1)) * DKS) = kr[j];
                    else *(LAS u32x4*)(lds + DVOFF + (buf ^ 1) * DVB + svoff + ((j >> 1) * 16 + 2 * (j & 1)) * 1024) = kr[j]; }
                if (hc == 0) {
#pragma unroll
                    for (int j = 0; j < 4; ++j) kr[j] = *(const u32x4*)(cn + (size_t)(64 * j) * PP + toffV); }
            }
        }
        __syncthreads();
        buf ^= 1;
    }
#undef DIL_K
#pragma unroll
    for (int q = 0; q < 2; ++q) {
        float l = st[q].l; l += __shfl_xor(l, 32);
        const float inv = 1.0f / l;
        const lp stg = lds + (128 * (2 * pr + q) + c + 4 * r) * DKS + 8 * h;
#pragma unroll
        for (int g = 0; g < 4; ++g) {
            u32x2 a; a.x = cvtpk(st[q].O0[4 * g] * inv, st[q].O0[4 * g + 1] * inv); a.y = cvtpk(st[q].O0[4 * g + 2] * inv, st[q].O0[4 * g + 3] * inv); *(LAS u32x2*)(stg + 16 * g) = a;
            u32x2 e; e.x = cvtpk(st[q].O1[4 * g] * inv, st[q].O1[4 * g + 1] * inv); e.y = cvtpk(st[q].O1[4 * g + 2] * inv, st[q].O1[4 * g + 3] * inv); *(LAS u32x2*)(stg + 64 + 16 * g) = e;
        }
    }
    __syncthreads();
    { bf16_t* Ob = obuf + (rowbase + T0) * DM + head * 64;
#pragma unroll
      for (int i = 0; i < 8; ++i) { const int p = wid * 64 + lane + 512 * i, row = p >> 3, cc = p & 7;
          const u32x4 v = *(const LAS u32x4*)(lds + row * DKS + cc * 16);
          *(u32x4*)(Ob + (size_t)row * DM + cc * 8) = v; } }
    __syncthreads();
}
}
#ifndef REP_DIFF
#define REP_DIFF 1
#endif
#ifndef REP_SB
#define REP_SB 1
#endif
#ifndef REP_PRO
#define REP_PRO 1
#endif
#ifndef REP_G
#define REP_G 1
#endif
#ifndef REP_SYNC
#define REP_SYNC 0
#endif
#ifndef REP_DIL
#define REP_DIL 1
#endif
#ifndef PHMASK
#define PHMASK 255
#endif
constexpr size_t MiB = (size_t)1 << 20;
constexpr size_t WS_SS = 0;
constexpr size_t WS_LUT = 2 * MiB, WS_BAR = 3 * MiB;
constexpr size_t WS_WINE = 4 * MiB, WS_WOUTE = 10 * MiB, WS_WINO = 12 * MiB, WS_WOUTO = 18 * MiB, WS_WUP = 20 * MiB, WS_WDN = 36 * MiB, WS_WG = 52 * MiB, WS_WPP = 56 * MiB;
constexpr size_t WS_HBA = 64 * MiB, WS_HBB = 192 * MiB;
constexpr size_t WS_PB = 320 * MiB;
constexpr size_t WS_BIG = 384 * MiB;
constexpr size_t WS_END = 896 * MiB;
constexpr int LDS_BYTES = 163840;
typedef unsigned short bf16;
typedef unsigned v4u __attribute__((ext_vector_type(4)));
typedef float f32x4 __attribute__((ext_vector_type(4)));

__device__ __forceinline__ unsigned f2bf(float f) { unsigned u = __builtin_bit_cast(unsigned, f); return (u + 0x7fffu + ((u >> 16) & 1u)) >> 16; }
__device__ __forceinline__ unsigned pk2(float lo, float hi) { return f2bf(lo) | (f2bf(hi) << 16); }
__device__ __forceinline__ float wave_sum(float v) {
#pragma unroll
    for (int o = 1; o < 64; o <<= 1) v += __shfl_xor(v, o);
    return v;
}
__device__ __forceinline__ void transpose_item(const float* W, int K, int N, bf16* WT, const float* g, LAS float* scr, int item, int lane) {
    const int nblk = N / 32, kb = item / nblk, nb = item % nblk, k0 = 64 * kb, n0 = 32 * nb;
#pragma unroll 8
    for (int i = 0; i < 32; ++i) { const int kk = 2 * i + (lane >> 5); scr[kk * 33 + (lane & 31)] = W[(size_t)(k0 + kk) * N + n0 + (lane & 31)]; }
    asm volatile("s_waitcnt lgkmcnt(0)" ::: "memory");
    const int c = lane & 7;
    float gs[8];
#pragma unroll
    for (int e = 0; e < 8; ++e) gs[e] = g ? g[k0 + 8 * c + e] : 1.0f;
#pragma unroll
    for (int j = 0; j < 4; ++j) { const int n = (lane >> 3) + 8 * j; const LAS float* s = scr + (8 * c) * 33 + n;
        v4u o; o.x = pk2(s[0 * 33] * gs[0], s[1 * 33] * gs[1]); o.y = pk2(s[2 * 33] * gs[2], s[3 * 33] * gs[3]); o.z = pk2(s[4 * 33] * gs[4], s[5 * 33] * gs[5]); o.w = pk2(s[6 * 33] * gs[6], s[7 * 33] * gs[7]);
        *(v4u*)(WT + (size_t)(n0 + n) * K + k0 + 8 * c) = o; }
    asm volatile("s_waitcnt lgkmcnt(0)" ::: "memory");
}
__device__ __forceinline__ int t5_bucket(int n) {
    if (n < 16) return n;
    const float v = logf((float)n / 16.0f) / 2.0794415416798357f * 16.0f;
    int l = 16 + (int)v; return l < 31 ? l : 31;
}

#define XB_TMO      128
#define XB_XCNT(j)  (256  + 64 * (j))
#define XB_XSUB(j)  (1280 + 64 * (j))
#define XB_XGEN(j)  (2304 + 64 * (j))
#define XB_TOP      3328
#define XB_TOPGEN   3392
#define XCD_BAR_WORDS 3456
#define XB_SPIN_CAP (1u << 18)

__device__ __forceinline__ unsigned xb_ld(unsigned* p)              { return __hip_atomic_load(p, __ATOMIC_RELAXED, __HIP_MEMORY_SCOPE_AGENT); }
__device__ __forceinline__ unsigned xb_add(unsigned* p, unsigned v) { return __hip_atomic_fetch_add(p, v, __ATOMIC_RELAXED, __HIP_MEMORY_SCOPE_AGENT); }
__device__ __forceinline__ unsigned xb_xcc_id() { return (unsigned)__builtin_amdgcn_s_getreg((3 << 11) | 20) & 0xFu; }
#define XB_SPIN(cond, bar) do { unsigned _sp = 0; while (cond) { __builtin_amdgcn_s_sleep(1); \
    if ((++_sp & 255u) == 0u) { if (xb_ld(&(bar)[XB_TMO])) break; if (_sp > XB_SPIN_CAP) { atomicAdd(&(bar)[XB_TMO], 1u); break; } } } } while (0)

struct XcdBarrier {
    unsigned* bar; unsigned x;
    volatile LAS unsigned* st;
};

__device__ __forceinline__ XcdBarrier xcd_barrier_post(unsigned* bar, volatile LAS unsigned* st) {
    XcdBarrier b; b.bar = bar; b.x = xb_xcc_id(); b.st = st;
    if (threadIdx.x == 0) (void)xb_add(&bar[XB_XCNT(b.x)], 1u);
    return b;
}
__device__ __forceinline__ void xcd_barrier_complete(unsigned* bar, unsigned x, unsigned& nloc, unsigned& nx) {
    const unsigned G = gridDim.x * gridDim.y * gridDim.z;
    unsigned sum, cnt, mine, sp = 0u;
    for (;;) {
        sum = 0u; cnt = 0u; mine = 0u;
#pragma unroll
        for (unsigned j = 0; j < 16; ++j) { const unsigned c = xb_ld(&bar[XB_XCNT(j)]); sum += c; cnt += (c > 0u) ? 1u : 0u; mine = (j == x) ? c : mine; }
        if (sum == G) break;
        __builtin_amdgcn_s_sleep(1);
        if ((++sp & 255u) == 0u) { if (xb_ld(&bar[XB_TMO])) break; if (sp > XB_SPIN_CAP) { atomicAdd(&bar[XB_TMO], 1u); break; } }
    }
    nloc = mine > 0u ? mine : 1u; nx = cnt > 0u ? cnt : 1u;
}

__device__ __forceinline__ void xcd_barrier(const XcdBarrier& b) {
    asm volatile("s_waitcnt vmcnt(0)" ::: "memory");
    __syncthreads();
    if (threadIdx.x == 0) {
        unsigned* bar = b.bar;
        __builtin_amdgcn_s_waitcnt(0);
        unsigned nloc = b.st[0], nx = b.st[1];
        if (nloc == 0u) { xcd_barrier_complete(bar, b.x, nloc, nx); b.st[0] = nloc; b.st[1] = nx; }
        const unsigned old = xb_add(&bar[XB_XSUB(b.x)], 1u);
        const unsigned gen = old / nloc;
        if (old + 1u == (gen + 1u) * nloc) {
            __builtin_amdgcn_fence(__ATOMIC_RELEASE, "agent");
            asm volatile("s_waitcnt vmcnt(0)" ::: "memory");
            const unsigned og = xb_add(&bar[XB_TOP], 1u);
            const unsigned tg = og / nx;
            if (og + 1u == (tg + 1u) * nx) xb_add(&bar[XB_TOPGEN], 1u);
            else XB_SPIN(xb_ld(&bar[XB_TOPGEN]) == tg, bar);
            __builtin_amdgcn_fence(__ATOMIC_ACQUIRE, "agent");
            xb_add(&bar[XB_XGEN(b.x)], 1u);
            asm volatile("s_waitcnt vmcnt(0)" ::: "memory");
        } else {
            XB_SPIN(xb_ld(&bar[XB_XGEN(b.x)]) == gen, bar);
            __builtin_amdgcn_fence(__ATOMIC_ACQUIRE, "agent");
            asm volatile("s_waitcnt vmcnt(0)" ::: "memory");
        }
    }
    __syncthreads();
}

struct Args { const float* in[20]; float* out; unsigned char* ws; };
enum { I_X = 0, I_P, I_T5, I_WINE, I_WOUTE, I_LQ1, I_LK1, I_LQ2, I_LK2, I_SUBG, I_WINO, I_WOUTO, I_GMIX, I_GMLP, I_WUP, I_WDN, I_GPLE, I_WG, I_WPP, I_GFIN };

__global__ void __launch_bounds__(512, 2) trunk_fwd(Args a) {
    extern __shared__ __attribute__((aligned(16))) unsigned char lds_raw[];
    cg::grid_group grid = cg::this_grid();
    LAS unsigned char* lds = (LAS unsigned char*)lds_raw;
    int tidp = threadIdx.x; asm volatile("" : "+v"(tidp));
    const int tid = tidp;
    const int G = gridDim.x, bx = blockIdx.x;
    const int vcu = (G % 8 == 0) ? (bx % 8) * (G / 8) + bx / 8 : bx;
    unsigned char* ws = a.ws;
    volatile LAS unsigned* bst = (volatile LAS unsigned*)(lds + LDS_BYTES - 64);
    if (tid < 2) bst[tid] = 0u;
#define WSP ({ unsigned char* w_ = a.ws; asm volatile("" : "+s"(w_)); w_; })
#define ssb ((float*)(WSP + WS_SS))
#define lutg ((float*)(WSP + WS_LUT))
#define hbA ((bf16*)(WSP + WS_HBA))
#define hbB ((bf16*)(WSP + WS_HBB))
#define pb ((bf16*)(WSP + WS_PB))
#define proj ((bf16*)(WSP + WS_BIG))
#define obuf ((bf16*)(WSP + WS_BIG + 384 * MiB))
#define ubuf ((bf16*)(WSP + WS_BIG))
#define ppb ((bf16*)(WSP + WS_BIG))
    unsigned* barw = (unsigned*)(WSP + WS_BAR);
    float* out = a.out;

    for (int rep = 0; rep < REP_PRO; ++rep) {
        const int lane = tid & 63, wave = __builtin_amdgcn_readfirstlane(tid >> 6);
        LAS float* scr = (LAS float*)(lds + wave * 16384);
        const int gw = vcu * 8 + wave, NGW = G * 8;
#define TR_ITEMS(K, N) (((K) / 64) * ((N) / 32))
        for (int it = gw; it < 13568; it += NGW) {
            int rr = it;
            if (rr < TR_ITEMS(1024, 3072)) { transpose_item(a.in[I_WINE], 1024, 3072, (bf16*)(WSP + WS_WINE), a.in[I_GMIX], scr, rr, lane); continue; } rr -= TR_ITEMS(1024, 3072);
            if (rr < TR_ITEMS(1024, 1024)) { transpose_item(a.in[I_WOUTE], 1024, 1024, (bf16*)(WSP + WS_WOUTE), nullptr, scr, rr, lane); continue; } rr -= TR_ITEMS(1024, 1024);
            if (rr < TR_ITEMS(1024, 3072)) { transpose_item(a.in[I_WINO], 1024, 3072, (bf16*)(WSP + WS_WINO), a.in[I_GMIX] + 1024, scr, rr, lane); continue; } rr -= TR_ITEMS(1024, 3072);
            if (rr < TR_ITEMS(1024, 1024)) { transpose_item(a.in[I_WOUTO], 1024, 1024, (bf16*)(WSP + WS_WOUTO), nullptr, scr, rr, lane); continue; } rr -= TR_ITEMS(1024, 1024);
            if (rr < 2 * TR_ITEMS(1024, 4096)) { const int L = rr / TR_ITEMS(1024, 4096); rr -= L * TR_ITEMS(1024, 4096);
                transpose_item(a.in[I_WUP] + (size_t)L * 1024 * 4096, 1024, 4096, (bf16*)(WSP + WS_WUP) + (size_t)L * 1024 * 4096, a.in[I_GMLP] + L * 1024, scr, rr, lane); continue; } rr -= 2 * TR_ITEMS(1024, 4096);
            if (rr < 2 * TR_ITEMS(4096, 1024)) { const int L = rr / TR_ITEMS(4096, 1024); rr -= L * TR_ITEMS(4096, 1024);
                transpose_item(a.in[I_WDN] + (size_t)L * 1024 * 4096, 4096, 1024, (bf16*)(WSP + WS_WDN) + (size_t)L * 1024 * 4096, nullptr, scr, rr, lane); continue; } rr -= 2 * TR_ITEMS(4096, 1024);
            if (rr < 2 * TR_ITEMS(1024, 1024)) { const int L = rr / TR_ITEMS(1024, 1024); rr -= L * TR_ITEMS(1024, 1024);
                transpose_item(a.in[I_WG] + (size_t)L * 1024 * 1024, 1024, 1024, (bf16*)(WSP + WS_WG) + (size_t)L * 1024 * 1024, a.in[I_GPLE] + L * 1024, scr, rr, lane); continue; } rr -= 2 * TR_ITEMS(1024, 1024);
            { const int L = rr / TR_ITEMS(256, 1024); rr -= L * TR_ITEMS(256, 1024);
                transpose_item(a.in[I_WPP] + (size_t)L * 256 * 1024, 256, 1024, (bf16*)(WSP + WS_WPP) + (size_t)L * 256 * 1024, nullptr, scr, rr, lane); }
        }
        const float* x = a.in[I_X];
        for (int m = gw; m < MTOK; m += 4 * NGW) {
            f32x4 v[4][4]; float s[4];
#pragma unroll
            for (int q = 0; q < 4; ++q) { const int mm = m + q * NGW; if (mm < MTOK) { const f32x4* xr = (const f32x4*)(x + (size_t)mm * DM) + lane;
#pragma unroll
                for (int j = 0; j < 4; ++j) v[q][j] = xr[64 * j]; } }
#pragma unroll
            for (int q = 0; q < 4; ++q) { const int mm = m + q * NGW; if (mm < MTOK) { float t = 0.f;
#pragma unroll
                for (int j = 0; j < 4; ++j) t += (v[q][j].x * v[q][j].x + v[q][j].y * v[q][j].y) + (v[q][j].z * v[q][j].z + v[q][j].w * v[q][j].w);
                s[q] = wave_sum(t);
                unsigned long long* o8 = (unsigned long long*)(hbB + (size_t)mm * DM) + lane;
#pragma unroll
                for (int j = 0; j < 4; ++j) o8[64 * j] = (unsigned long long)pk2(v[q][j].x, v[q][j].y) | ((unsigned long long)pk2(v[q][j].z, v[q][j].w) << 32);
                if (lane == 0) ssb[mm] = s[q]; } }
        }
        { const f32x4* p4 = (const f32x4*)a.in[I_P]; unsigned long long* o8 = (unsigned long long*)pb;
          const size_t n4 = (size_t)2 * MTOK * PLED / 4, stride = (size_t)G * 512;
          for (size_t i = (size_t)bx * 512 + tid; i < n4; i += 4 * stride) { f32x4 v[4];
#pragma unroll
              for (int q = 0; q < 4; ++q) if (i + q * stride < n4) v[q] = p4[i + q * stride];
#pragma unroll
              for (int q = 0; q < 4; ++q) if (i + q * stride < n4) o8[i + q * stride] = (unsigned long long)pk2(v[q].x, v[q].y) | ((unsigned long long)pk2(v[q].z, v[q].w) << 32); } }
        { const size_t n = (size_t)6 * MTOK, stride = (size_t)G * 512; float* z = ssb + MTOK;
          for (size_t i = (size_t)bx * 512 + tid; i < n; i += stride) z[i] = 0.f; }
        if (bx == 0) for (int i = tid; i < XCD_BAR_WORDS; i += 512) barw[i] = 0u;
        if (bx == 0) { const float* tab = a.in[I_T5];
            for (int i = tid; i < 16 * 129; i += 512) { const int slot = i / 129, d = i % 129; lutg[slot * LUTS + d] = tab[t5_bucket(d) * 16 + slot] * LOG2E; } }
    }
    grid.sync();
    const XcdBarrier xbar = xcd_barrier_post(barw, bst);
#pragma unroll 1
    for (int i = 0; i < REP_SYNC; ++i) xcd_barrier(xbar);

    float lam;
    { float s1 = 0.f, s2 = 0.f;
      for (int i = 0; i < 64; ++i) { s1 += a.in[I_LQ1][i] * a.in[I_LK1][i]; s2 += a.in[I_LQ2][i] * a.in[I_LK2][i]; }
      lam = expf(s1) - expf(s2) + 0.2f; lam = __uint_as_float(__builtin_amdgcn_readfirstlane(__float_as_uint(lam))); }

#pragma unroll 1
    for (int L = 0; L < 2; ++L) {
        float* ss_in0 = ssb + (size_t)(3 * L) * MTOK;
        float* ss_a = ssb + (size_t)(3 * L + 1) * MTOK;
        float* ss_b = ssb + (size_t)(3 * L + 2) * MTOK;
        float* ss_c = ssb + (size_t)(3 * L + 3) * MTOK;
#if PHMASK & 1
#pragma unroll 1
        for (int rep = 0; rep < REP_G; ++rep)
        { pg8::Gemm g{hbB, (const bf16*)(WSP + (L == 0 ? WS_WINE : WS_WINO)), MTOK, NPROJ, DM}; pg8::StaticOrder S; S.init(MTOK, NPROJ, G, bx);
          pg8::EpiNormBf16<0, true> E{proj, MTOK, ss_in0};
          pg8::gemm_phase<pg8::EpiNormBf16<0, true>, pg8::StaticOrder, true, true>(lds, g, S, E); }
#endif
        xcd_barrier(xbar);
#if PHMASK & 2
        if (L == 0) {
#ifdef PROBE_UNIT_OVERHEAD
#ifndef PROBE_MODE
#define PROBE_MODE 0
#endif
            if (G == 256) { const int bh = vcu >> 3, sidx = vcu & 7;
#pragma unroll 1
                for (int i = 0; i < 8; ++i) { const int qb = 8 * i + ((sidx + i) & 7); att::diff_unit(bh >> 2, bh & 3, qb, proj, obuf, lutg, lam, a.in[I_SUBG], lds, PROBE_UNIT_OVERHEAD, PROBE_MODE); } }
#endif
            for (int rep = 0; rep < REP_DIFF; ++rep)
            if (G == 256) {
                const int bh = vcu >> 3, sidx = vcu & 7;
#pragma unroll 1
                for (int i = 0; i < 8; ++i) { const int qb = 8 * i + ((sidx + i) & 7);
                    att::diff_unit(bh >> 2, bh & 3, qb, proj, obuf, lutg, lam, a.in[I_SUBG], lds); }
            } else {
#pragma unroll 1
                for (int u = vcu; u < 2048; u += G) { const int bh = u & 31, qb = 63 - (u >> 5); att::diff_unit(bh >> 2, bh & 3, qb, proj, obuf, lutg, lam, a.in[I_SUBG], lds); }
            }
            for (int rep = 0; rep < REP_SB; ++rep)
#pragma unroll 1
            for (int u = vcu; u < 2048; u += G) { const int bh = u & 63, qb = u >> 6; att::sb_unit(bh >> 3, bh & 7, qb, proj, obuf, lds); }
        }
#endif
#if PHMASK & 4
        if (L == 1) {
            for (int rep = 0; rep < REP_DIL; ++rep)
#pragma unroll 1
            for (int i = 0; i * G + vcu < 2048; ++i) {
                int b, head, span;
                if (G == 256) { const int j = vcu & 31, combo = i * 16 + 2 * (vcu >> 5) + (j >> 4); b = combo >> 4; head = combo & 15; span = ((j & 15) + 4 * (i >> 1)) & 15; if ((i & 1) && span < 4) span = 3 - span; }
                else { const int u = i * G + vcu; span = u & 15; head = (u >> 4) & 15; b = u >> 8; }
                att::dil_unit(b, head, span, proj, obuf, lutg, lds);
            }
        }
#endif
        xcd_barrier(xbar);
#if PHMASK & 8
        { pg8::Gemm g{obuf, (const bf16*)(WSP + (L == 0 ? WS_WOUTE : WS_WOUTO)), MTOK, DM, DM}; pg8::StaticOrder S; S.init(MTOK, DM, G, bx);
          pg8::EpiResid<false> E{nullptr, hbB, hbA, ss_a};
          pg8::gemm_phase<pg8::EpiResid<false>, pg8::StaticOrder, true, true>(lds, g, S, E); }
#endif
        xcd_barrier(xbar);
#if PHMASK & 16
#pragma unroll 1
        for (int rep = 0; rep < REP_G; ++rep)
        { pg8::Gemm g{hbA, (const bf16*)(WSP + WS_WUP) + (size_t)L * DM * DFF, MTOK, DFF, DM}; pg8::StaticOrder S; S.init(MTOK, DFF, G, bx);
          pg8::EpiNormBf16<1> E{ubuf, DFF, ss_a};
          pg8::gemm_phase<pg8::EpiNormBf16<1>, pg8::StaticOrder, true, true>(lds, g, S, E); }
#endif
        xcd_barrier(xbar);
#if PHMASK & 32
        { pg8::Gemm g{ubuf, (const bf16*)(WSP + WS_WDN) + (size_t)L * DM * DFF, MTOK, DM, DFF}; pg8::StaticOrder S; S.init(MTOK, DM, G, bx);
          pg8::EpiResid<false> E{nullptr, hbA, hbA, ss_b};
          pg8::gemm_phase<pg8::EpiResid<false>, pg8::StaticOrder, true, true>(lds, g, S, E); }
#endif
        xcd_barrier(xbar);
#if PHMASK & 64
        { int kpp = PLED; asm volatile("" : "+s"(kpp)); pg8::Gemm g{pb + (size_t)L * MTOK * PLED, (const bf16*)(WSP + WS_WPP) + (size_t)L * PLED * DM, MTOK, DM, kpp}; pg8::StaticOrder S; S.init(MTOK, DM, G, bx);
          pg8::EpiNormBf16<0> E{ppb, DM, nullptr};
          pg8::gemm_phase<pg8::EpiNormBf16<0>, pg8::StaticOrder, true, true>(lds, g, S, E); }
#endif
#if PHMASK & 128
        { pg8::Gemm g{hbA, (const bf16*)(WSP + WS_WG) + (size_t)L * DM * DM, MTOK, DM, DM}; pg8::StaticOrder S; S.init(MTOK, DM, G, bx);
          pg8::EpiGate E{hbA, hbB, ss_c, ss_b, ppb};
          pg8::gemm_phase<pg8::EpiGate, pg8::StaticOrder, true, true>(lds, g, S, E); }
#endif
        xcd_barrier(xbar);
    }
    { int tidf = threadIdx.x; asm volatile("" : "+v"(tidf)); const int lane = tidf & 63, wave = __builtin_amdgcn_readfirstlane(tidf >> 6);
      const int gw = bx * 8 + wave, NGW = G * 8; const float* ss = ssb + (size_t)6 * MTOK; const f32x4* g4 = (const f32x4*)a.in[I_GFIN] + 2 * lane;
      f32x4 gv[4];
#pragma unroll
      for (int j = 0; j < 2; ++j) { gv[2 * j] = g4[128 * j]; gv[2 * j + 1] = g4[128 * j + 1]; }
      for (int m = gw; m < MTOK; m += 4 * NGW) {
          v4u w[4][2]; float rs[4];
#pragma unroll
          for (int q = 0; q < 4; ++q) { const int mm = m + q * NGW; if (mm < MTOK) { const v4u* hi = (const v4u*)(hbB + (size_t)mm * DM) + lane; w[q][0] = hi[0]; w[q][1] = hi[64]; rs[q] = ss[mm]; } }
#pragma unroll
          for (int q = 0; q < 4; ++q) { const int mm = m + q * NGW; if (mm < MTOK) { const float r = __builtin_amdgcn_rsqf(rs[q] * (1.0f / 1024.0f) + 1e-6f);
              f32x4* o = (f32x4*)(out + (size_t)mm * DM) + 2 * lane;
#pragma unroll
              for (int j = 0; j < 2; ++j) { f32x4 p0, p1; pg8::unpack8(w[q][j], p0, p1); o[128 * j] = p0 * r * gv[2 * j]; o[128 * j + 1] = p1 * r * gv[2 * j + 1]; } } }
      } }
}

#undef ssb
#undef lutg
#undef hbA
#undef hbB
#undef pb
#undef proj
#undef obuf
#undef ubuf
#undef ppb
extern "C" void kernel_launch(void* const* d_in, const int* in_sizes, int n_in, void* d_out, int out_size, void* d_ws, size_t ws_size, hipStream_t stream) {
    static int grid_blocks = 0;
    if (grid_blocks == 0) {
        if (n_in != 20 || in_sizes[0] != MTOK * DM || out_size != MTOK * DM || ws_size < WS_END) {
            fprintf(stderr, "kernel_launch: unexpected shapes (n_in %d, in0 %d, out %d, ws %zu); nothing launched\n", n_in, n_in > 0 ? in_sizes[0] : -1, out_size, ws_size); grid_blocks = -1; return; }
        int dev = 0, cus = 0, per_cu = 0;
        (void)hipGetDevice(&dev); (void)hipDeviceGetAttribute(&cus, hipDeviceAttributeMultiprocessorCount, dev);
        if (hipFuncSetAttribute((const void*)trunk_fwd, hipFuncAttributeMaxDynamicSharedMemorySize, LDS_BYTES) != hipSuccess) { fprintf(stderr, "kernel_launch: hipFuncSetAttribute failed\n"); grid_blocks = -1; return; }
        if (hipOccupancyMaxActiveBlocksPerMultiprocessor(&per_cu, (const void*)trunk_fwd, 512, LDS_BYTES) != hipSuccess || per_cu < 1) { fprintf(stderr, "kernel_launch: occupancy query says %d blocks per CU\n", per_cu); per_cu = 1; }
        (void)hipGetLastError();
        grid_blocks = cus * per_cu;
    }
    if (grid_blocks < 0) return;
    Args a{};
    for (int i = 0; i < 20; ++i) a.in[i] = (const float*)d_in[i];
    a.out = (float*)d_out; a.ws = (unsigned char*)d_ws;
    void* args[] = {&a};
    hipError_t e = hipLaunchCooperativeKernel((const void*)trunk_fwd, dim3(grid_blocks), dim3(512), args, LDS_BYTES, stream);
    if (e != hipSuccess) fprintf(stderr, "cooperative launch failed: %s (grid %d)\n", hipGetErrorString(e), grid_blocks);
}
```
